# Optimizing an MI355X kernel written in HIP

```python
import jax, jax.numpy as jnp
from jax import lax
import numpy as np

D_MODEL = 2048
BATCH = 32
SEQ = 256
DEPTH = 4
DEC_BATCH = 8
DEC_SEQ = 2048
PAST_LEN = 256

GRID_W = 64
MIX_WIDTH = D_MODEL
GLA_WIDTH = MIX_WIDTH // 2
POOL_WIDTH = MIX_WIDTH - GLA_WIDTH
GLA_HEADS = 4
GLA_DV = GLA_WIDTH // GLA_HEADS
GLA_DK = GLA_DV // 2
GLA_KEY_WIDTH = GLA_HEADS * GLA_DK
GLA_GATE_RANK = 16
GLA_GATE_TEMP = 16.0
GLA_CHUNK = 64
POOL_WINDOWS = (2, 4, 8, 16)
POOL_GROUPS = len(POOL_WINDOWS)
POOL_GROUP_DIM = POOL_WIDTH // POOL_GROUPS
D_FF = ((8 * D_MODEL + 2) // 3 + 255) // 256 * 256
ALPHA = (2 * DEPTH) ** 0.25
BETA = (8 * DEPTH) ** -0.25
LN_EPS = 1e-5
Q_OFF = 0
K_OFF = Q_OFF + GLA_KEY_WIDTH
V_OFF = K_OFF + GLA_KEY_WIDTH
G_OFF = V_OFF + GLA_WIDTH
AF_OFF = G_OFF + GLA_WIDTH
AB_OFF = AF_OFF + GLA_GATE_RANK
P_OFF = AB_OFF + GLA_GATE_RANK
IN_WIDTH = P_OFF + POOL_WIDTH

kernel_name = 'hymba_gla_pool_dit_step'


def layer_norm(x, g, b):
    xf = x.astype(jnp.float32)
    mu = jnp.mean(xf, axis=-1, keepdims=True)
    var = jnp.mean(jnp.square(xf - mu), axis=-1, keepdims=True)
    y = (xf - mu) * lax.rsqrt(var + LN_EPS) * g.astype(jnp.float32) + b.astype(jnp.float32)
    return y.astype(x.dtype)


def gla_chunked(q, k, v, log_a, s0):
    B, H, L, dk = q.shape
    dv = v.shape[-1]
    n = L // GLA_CHUNK
    r = lambda t: t.reshape(B, H, n, GLA_CHUNK, t.shape[-1])
    q, k, v, log_a = r(q), r(k), r(v), r(log_a)
    b = jnp.cumsum(log_a, axis=3)
    b_last = b[..., -1:, :]
    qe = q * jnp.exp(b)
    ke = k * jnp.exp(-b)
    kd = k * jnp.exp(b_last - b)
    order = jnp.tril(jnp.ones((GLA_CHUNK, GLA_CHUNK), dtype=bool))
    A = jnp.where(order, jnp.einsum('bhncd,bhnsd->bhncs', qe, ke), 0.0)
    o_intra = jnp.einsum('bhncs,bhnsv->bhncv', A, v)
    U = jnp.einsum('bhncd,bhncv->bhndv', kd, v)
    decay = jnp.exp(b_last[..., 0, :])

    def step(S, inp):
        d, u = inp
        return d[..., None] * S + u, S

    s_final, s_before = lax.scan(step, s0, (jnp.moveaxis(decay, 2, 0), jnp.moveaxis(U, 2, 0)))
    s_before = jnp.moveaxis(s_before, 0, 2)
    o = o_intra + jnp.einsum('bhncd,bhndv->bhncv', qe, s_before)
    return o.reshape(B, H, L, dv), s_final


def _window_bounds(n, w):
    idx = jnp.arange(n)
    lo = jnp.clip(idx - w // 2, 0, n)
    hi = jnp.clip(idx - w // 2 + w, 0, n)
    return lo, hi


def pool_1d(p, w):
    L = p.shape[1]
    P = jnp.concatenate([jnp.zeros_like(p[:, :1]), jnp.cumsum(p, axis=1)], axis=1)
    lo, hi = _window_bounds(L, w)
    cnt = (hi - lo).astype(p.dtype)
    return (P[:, hi] - P[:, lo]) / cnt[None, :, None] - p


def pool_2d(p, w):
    B, L, C = p.shape
    rows = L // GRID_W
    g = p.reshape(B, rows, GRID_W, C)
    P = jnp.pad(jnp.cumsum(jnp.cumsum(g, axis=1), axis=2), ((0, 0), (1, 0), (1, 0), (0, 0)))
    lr, hr = _window_bounds(rows, w)
    lc, hc = _window_bounds(GRID_W, w)
    Ph = P[:, hr]
    Pl = P[:, lr]
    s = Ph[:, :, hc] - Pl[:, :, hc] - Ph[:, :, lc] + Pl[:, :, lc]
    cnt = ((hr - lr)[:, None] * (hc - lc)[None, :]).astype(p.dtype)
    return (s / cnt[None, :, :, None] - g).reshape(B, L, C)


def mixer(h, s0_f, s0_b, on_grid, w_in, w_a2, b_a, gla_norm_g, w_pool, pool_scale, w_out):
    B, L, _ = h.shape
    f32 = jnp.float32
    z = h @ w_in
    q, k, v, g, a_f, a_b, p = jnp.split(z, [K_OFF, V_OFF, G_OFF, AF_OFF, AB_OFF, P_OFF], axis=-1)
    heads = lambda t, d: t.astype(f32).reshape(B, L, GLA_HEADS, d).transpose(0, 2, 1, 3)
    q = heads(q, GLA_DK) * (GLA_DK ** -0.5)
    k = heads(k, GLA_DK)
    v = heads(v, GLA_DV)
    log_a_f = heads(jax.nn.log_sigmoid((a_f @ w_a2[0] + b_a[0]).astype(f32)) / GLA_GATE_TEMP, GLA_DK)
    log_a_b = heads(jax.nn.log_sigmoid((a_b @ w_a2[1] + b_a[1]).astype(f32)) / GLA_GATE_TEMP, GLA_DK)
    flip = lambda t: jnp.flip(t, axis=2)
    o_f, s_f = gla_chunked(q, k, v, log_a_f, s0_f.astype(f32))
    o_b, s_b = gla_chunked(flip(q), flip(k), flip(v), flip(log_a_b), s0_b.astype(f32))
    o = (o_f + flip(o_b)).transpose(0, 2, 1, 3)
    o = o * lax.rsqrt(jnp.mean(jnp.square(o), axis=-1, keepdims=True) + LN_EPS)
    o = o * gla_norm_g.astype(f32).reshape(GLA_HEADS, GLA_DV)
    o = o.reshape(B, L, GLA_WIDTH) * jax.nn.silu(g.astype(f32))
    pf = p.astype(f32)
    pool_fn = pool_2d if on_grid else pool_1d
    pooled = jnp.stack([pool_fn(pf[..., i * POOL_GROUP_DIM:(i + 1) * POOL_GROUP_DIM], w)
                        for i, w in enumerate(POOL_WINDOWS)], axis=2)
    y_pool = jnp.einsum('blgc,gcd->blgd', pooled, w_pool).reshape(B, L, POOL_WIDTH)
    y_pool = y_pool * pool_scale.astype(f32)
    mixed = jnp.concatenate([o, y_pool], axis=-1).astype(h.dtype)
    return mixed @ w_out, s_f, s_b


def block(x, mod, s0_f, s0_b, on_grid, w_in, w_a2, b_a, gla_norm_g, w_pool, pool_scale, w_out,
          ln1_g, ln1_b, w_gu, w_down, ln2_g, ln2_b):
    sh1, sc1, g1, sh2, sc2, g2 = jnp.split(mod, 6, axis=-1)
    h = x * (1 + sc1) + sh1
    m, s_f, s_b = mixer(h, s0_f, s0_b, on_grid, w_in, w_a2, b_a, gla_norm_g, w_pool, pool_scale, w_out)
    x = layer_norm(ALPHA * x + g1 * m, ln1_g, ln1_b)
    h = x * (1 + sc2) + sh2
    gate, up = jnp.split(h @ w_gu, 2, axis=-1)
    f = (jax.nn.silu(gate) * up) @ w_down
    x = layer_norm(ALPHA * x + g2 * f, ln2_g, ln2_b)
    return x, s_f, s_b


def setup_inputs(seed: int = 0) -> dict:
    key = jax.random.key(seed)
    ks = jax.random.split(key, 22)
    nrm = lambda k, shape, s: jax.random.normal(k, shape, jnp.float32) * s
    return {
        'x_prompt': nrm(ks[0], (BATCH, SEQ, D_MODEL), 1.0),
        'x_sample': nrm(ks[1], (DEC_BATCH, DEC_SEQ, D_MODEL), 1.0),
        'state_gla': nrm(ks[2], (DEPTH, 2, DEC_BATCH, GLA_HEADS, GLA_DK, GLA_DV), 0.5),
        'c': nrm(ks[3], (DEC_BATCH, D_MODEL), 1.0),
        'c_ctx': nrm(ks[4], (D_MODEL,), 1.0),
        'ln_in_g': 1.0 + nrm(ks[5], (D_MODEL,), 0.05),
        'ln_in_b': nrm(ks[6], (D_MODEL,), 0.02),
        'w_ada': nrm(ks[7], (DEPTH, D_MODEL, 6 * D_MODEL), 0.5 * D_MODEL ** -0.5),
        'b_ada': nrm(ks[8], (DEPTH, 6 * D_MODEL), 0.02),
        'w_in': nrm(ks[9], (DEPTH, D_MODEL, IN_WIDTH), D_MODEL ** -0.5),
        'w_a2': nrm(ks[10], (DEPTH, 2, GLA_GATE_RANK, GLA_KEY_WIDTH), GLA_GATE_RANK ** -0.5),
        'b_a': nrm(ks[11], (DEPTH, 2, GLA_KEY_WIDTH), 0.5),
        'gla_norm_g': 1.0 + nrm(ks[12], (DEPTH, GLA_WIDTH), 0.05),
        'w_pool': nrm(ks[13], (DEPTH, POOL_GROUPS, POOL_GROUP_DIM, POOL_GROUP_DIM), POOL_GROUP_DIM ** -0.5),
        'pool_scale': 1.0 + nrm(ks[14], (DEPTH, POOL_WIDTH), 0.1),
        'w_out': nrm(ks[15], (DEPTH, MIX_WIDTH, D_MODEL), BETA * MIX_WIDTH ** -0.5),
        'ln1_g': 1.0 + nrm(ks[16], (DEPTH, D_MODEL), 0.05),
        'ln1_b': nrm(ks[17], (DEPTH, D_MODEL), 0.02),
        'w_gu': nrm(ks[18], (DEPTH, D_MODEL, 2 * D_FF), D_MODEL ** -0.5),
        'w_down': nrm(ks[19], (DEPTH, D_FF, D_MODEL), BETA * D_FF ** -0.5),
        'ln2_g': 1.0 + nrm(ks[20], (DEPTH, D_MODEL), 0.05),
        'ln2_b': nrm(ks[21], (DEPTH, D_MODEL), 0.02),
    }


def reference(x_prompt, x_sample, state_gla, c, c_ctx, ln_in_g, ln_in_b, w_ada, b_ada, w_in, w_a2,
              b_a, gla_norm_g, w_pool, pool_scale, w_out, ln1_g, ln1_b, w_gu, w_down, ln2_g, ln2_b):
    xp = layer_norm(x_prompt, ln_in_g, ln_in_b)
    xs = layer_norm(x_sample, ln_in_g, ln_in_b)
    zero_state = jnp.zeros((x_prompt.shape[0], GLA_HEADS, GLA_DK, GLA_DV), jnp.float32)
    states = []
    for l in range(DEPTH):
        lw = (w_in[l], w_a2[l], b_a[l], gla_norm_g[l], w_pool[l], pool_scale[l], w_out[l],
              ln1_g[l], ln1_b[l], w_gu[l], w_down[l], ln2_g[l], ln2_b[l])
        mod_ctx = jax.nn.silu(c_ctx) @ w_ada[l] + b_ada[l]
        mod_lat = (jax.nn.silu(c) @ w_ada[l] + b_ada[l])[:, None, :]
        xp, s_f, s_b = block(xp, mod_ctx, zero_state, zero_state, False, *lw)
        states.append(jnp.stack([s_f, s_b], axis=0))
        xs, _, _ = block(xs, mod_lat, state_gla[l, 0], state_gla[l, 1], True, *lw)
    y_prompt = xp
    y_sample = xs
    new_state_gla = jnp.stack(states, axis=0).astype(x_prompt.dtype)
    return (y_prompt, y_sample, new_state_gla)
```

```cpp
#include <hip/hip_runtime.h>
#include <cstdio>
#include <cstdint>

#define LAS __attribute__((address_space(3)))
typedef unsigned short bf16_t;
typedef short bf16x8 __attribute__((ext_vector_type(8)));
typedef short s16x4 __attribute__((ext_vector_type(4)));
typedef float f32x4 __attribute__((ext_vector_type(4)));
typedef float f32x2 __attribute__((ext_vector_type(2)));
typedef unsigned u32x4 __attribute__((ext_vector_type(4)));
typedef unsigned u32x2 __attribute__((ext_vector_type(2)));

constexpr int D = 2048, DEPTH = 4;
constexpr int NB_P = 32, L_P = 256, NB_S = 8, L_S = 2048;
constexpr int MP = NB_P * L_P, MS = NB_S * L_S, MT = MP + MS;
constexpr int GH = 4, DK = 128, DV = 256, KW = 512, GW = 1024, PW = 1024, RANK = 16;
constexpr int INW = 4128, NZ = 4096, DFF = 5632, NGU = 2 * DFF;
constexpr int NMOD = 9, MODW = 6 * D;
constexpr float LN_EPS = 1e-5f;
constexpr float ALPHA = 1.681792830507429f;
constexpr float QSCALE = 0.08838834764831845f;
constexpr int NCHUNK = MT / 64;
constexpr int NPREP = NCHUNK * GH * 2;

constexpr size_t MiB = 1u << 20;
constexpr size_t WS_CTL = 0, CTL_ZERO_BYTES = 128 * 1024;
constexpr size_t WS_MODS = 1 * MiB;
constexpr size_t WS_WG = 3 * MiB;
constexpr size_t WS_WPOOL = 4 * MiB;
constexpr size_t WS_WIN = 6 * MiB;
constexpr size_t WS_WOUT = 70 * MiB;
constexpr size_t WS_WIN8 = 190 * MiB;
constexpr size_t WS_WGU = 102 * MiB;
constexpr size_t WS_WDN = 278 * MiB;
constexpr size_t WS_X = 366 * MiB;
constexpr size_t WS_H = 558 * MiB;
constexpr size_t WS_MB = 654 * MiB;
constexpr size_t WS_POOLED = 846 * MiB;
constexpr size_t WS_GATES = 894 * MiB;
constexpr size_t WS_Z = 898 * MiB;
constexpr size_t WS_OF = 1090 * MiB;
constexpr size_t WS_OB = 1138 * MiB;
constexpr size_t WS_MIXED = 1186 * MiB;
constexpr size_t WS_QE = 1282 * MiB;
constexpr size_t WS_KDT = 1330 * MiB;
constexpr size_t WS_AM = 1378 * MiB;
constexpr size_t WS_DEC = 1402 * MiB;
constexpr size_t WS_END = 1404 * MiB;
constexpr size_t WS_ACT = 898 * MiB;
static_assert(WS_ACT + (size_t)MT * DFF * 2 <= WS_MIXED, "ACT overlay");
constexpr int CW_BAR = 4096;

constexpr int RING_BYTES = 131072;
constexpr int MISC_OFF = RING_BYTES;
constexpr int LDS_BYTES = 147456;

__device__ __forceinline__ unsigned f2bf(float f) { unsigned u = __builtin_bit_cast(unsigned, f); return (u + 0x7fffu + ((u >> 16) & 1u)) >> 16; }
__device__ __forceinline__ unsigned pk2(float lo, float hi) { return f2bf(lo) | (f2bf(hi) << 16); }
__device__ __forceinline__ float bf2f(unsigned short b) { return __builtin_bit_cast(float, ((unsigned)b) << 16); }
__device__ __forceinline__ float bflo(unsigned w) { return __builtin_bit_cast(float, w << 16); }
__device__ __forceinline__ float bfhi(unsigned w) { return __builtin_bit_cast(float, w & 0xffff0000u); }
__device__ __forceinline__ float wave_sum(float v) {
#pragma unroll
    for (int o = 1; o < 64; o <<= 1) v += __shfl_xor(v, o);
    return v;
}
typedef _Float16 f16x2 __attribute__((ext_vector_type(2)));
__device__ __forceinline__ unsigned pkh2(float lo, float hi) { const f16x2 v = {(_Float16)lo, (_Float16)hi}; return __builtin_bit_cast(unsigned, v); }
__device__ __forceinline__ float h2lo(unsigned w) { return (float)__builtin_bit_cast(f16x2, w)[0]; }
__device__ __forceinline__ float h2hi(unsigned w) { return (float)__builtin_bit_cast(f16x2, w)[1]; }
__device__ __forceinline__ float silu_f(float x) { return x / (1.0f + __expf(-x)); }

namespace pg8 {
#define PG8_LAS __attribute__((address_space(3)))
constexpr int BM = 256, BK = 64, HALF = 128, HTB = HALF * BK * 2  , STAGE_BYTES = 8 * HTB, NXCD = 8, WGM = 4;

__host__ __device__ __forceinline__ int lds_byte(int r, int c) { const int st = (r >> 4) * 2 + (c >> 5), rr = r & 15, cc = c & 31, ob = rr * 64 + cc * 2; return st * 1024 + (ob ^ (((ob >> 9) & 1) << 5)); }
__host__ __device__ __forceinline__ void stage_rc(int b, int& R, int& C) { const int st = b / 1024, sb = b % 1024, swz = sb ^ (((sb >> 9) & 1) << 5); R = (st >> 1) * 16 + swz / 64; C = (st & 1) * 32 + (swz % 64) / 2; }
__host__ __device__ __forceinline__ int perm32(int rho) { const int n = rho >> 4, i = rho & 15; return 8 * (i >> 2) + 4 * n + (i & 3); }

struct Unit { int pm, pn; };
struct Gemm { const bf16_t* A; const bf16_t* Bt; int M, N, K, lda, ldb, a_pn_off; };

struct StaticOrder {
    int nM, nN, nwg, G, c;
    __host__ __device__ void init(int M, int N, int G_, int c_) { nM = M / BM; nN = N / BM; nwg = nM * nN; G = G_; c = c_; }
    __host__ __device__ bool next(int i, Unit& u) const {
        const long L = (long)i * G + c; if (c < 0 || L >= nwg) return false;
        int wgid = (int)L; { const int q = nwg / NXCD, r = nwg % NXCD, xcd = wgid % NXCD, off = wgid / NXCD; wgid = (xcd < r ? xcd * (q + 1) : r * (q + 1) + (xcd - r) * q) + off; }
        const int nig = WGM * nN, gid = wgid / nig, fm = gid * WGM, gsz = (nM - fm) < WGM ? (nM - fm) : WGM;
        u.pm = fm + ((wgid % nig) % gsz); u.pn = (wgid % nig) / gsz; return true;
    }
    __device__ __forceinline__ void a_ready(const Unit&) const {}
    __device__ __forceinline__ void done(const Unit&) const {}
};

__device__ __forceinline__ unsigned cvt_pk_bf16(float lo, float hi) { unsigned r; asm volatile("v_cvt_pk_bf16_f32 %0, %1, %2" : "=v"(r) : "v"(lo), "v"(hi)); return r; }

struct EpiF32 {
    static constexpr bool PERM = false, AFTER_DRAIN = false;
    float* C; int ldc; float sc;
    __device__ __forceinline__ void operator()(const f32x4 (&acc)[2][2][4][2], const Unit& u, int wr, int wc, int fr, int fq) const {
        const int row0 = u.pm * BM + wr * 64 + fr, col0 = u.pn * BM + wc * 32 + 4 * fq;
#pragma unroll
        for (int ai = 0; ai < 2; ++ai)
#pragma unroll
            for (int m = 0; m < 4; ++m) { float* rowp = C + (size_t)(row0 + ai * HALF + m * 16) * ldc + col0;
#pragma unroll
                for (int bj = 0; bj < 2; ++bj)
#pragma unroll
                    for (int n = 0; n < 2; ++n) *(f32x4*)(rowp + bj * HALF + n * 16) = acc[ai][bj][m][n] * sc; }
    }
};
__device__ __forceinline__ unsigned pk_fp8x4(float a, float b, float c, float d) {
    int w = 0;
    w = __builtin_amdgcn_cvt_pk_fp8_f32(__builtin_amdgcn_fmed3f(a, -448.f, 448.f), __builtin_amdgcn_fmed3f(b, -448.f, 448.f), w, false);
    w = __builtin_amdgcn_cvt_pk_fp8_f32(__builtin_amdgcn_fmed3f(c, -448.f, 448.f), __builtin_amdgcn_fmed3f(d, -448.f, 448.f), w, true);
    return (unsigned)w;
}
struct EpiFp8Col {
    static constexpr bool PERM = true, AFTER_DRAIN = false;
    unsigned char* O; int ldc; const float* scale; float usc;
    __device__ __forceinline__ void operator()(const f32x4 (&acc)[2][2][4][2], const Unit& u, int wr, int wc, int fr, int fq) const {
        const int row0 = u.pm * BM + wr * 64 + fr; const int col0 = u.pn * BM + wc * 32 + 8 * fq;
#pragma unroll
        for (int bj = 0; bj < 2; ++bj) {
            const f32x4 s0 = *(const f32x4*)(scale + col0 + bj * HALF) * usc, s1 = *(const f32x4*)(scale + col0 + bj * HALF + 4) * usc;
#pragma unroll
            for (int ai = 0; ai < 2; ++ai)
#pragma unroll
                for (int m = 0; m < 4; ++m) { unsigned char* rowp = O + (size_t)(row0 + ai * HALF + m * 16) * ldc + col0 + bj * HALF;
                    const f32x4 v0 = acc[ai][bj][m][0] * s0, v1 = acc[ai][bj][m][1] * s1;
                    u32x2 w; w.x = pk_fp8x4(v0[0], v0[1], v0[2], v0[3]); w.y = pk_fp8x4(v1[0], v1[1], v1[2], v1[3]);
                    *(u32x2*)rowp = w; } }
    }
};
template <bool SCALED> struct EpiBf16 {
    static constexpr bool PERM = true, AFTER_DRAIN = false;
    bf16_t* O; int ldc; const float* scale; float usc;
    __device__ __forceinline__ void operator()(const f32x4 (&acc)[2][2][4][2], const Unit& u, int wr, int wc, int fr, int fq) const {
        const int row0 = u.pm * BM + wr * 64 + fr; const int col0 = u.pn * BM + wc * 32 + 8 * fq;
#pragma unroll
        for (int bj = 0; bj < 2; ++bj) {
            f32x4 s0 = {usc, usc, usc, usc}, s1 = {usc, usc, usc, usc};
            if (SCALED) { s0 = *(const f32x4*)(scale + col0 + bj * HALF); s1 = *(const f32x4*)(scale + col0 + bj * HALF + 4); }
#pragma unroll
            for (int ai = 0; ai < 2; ++ai)
#pragma unroll
                for (int m = 0; m < 4; ++m) { bf16_t* rowp = O + (size_t)(row0 + ai * HALF + m * 16) * ldc + col0 + bj * HALF;
                    f32x4 v0 = acc[ai][bj][m][0], v1 = acc[ai][bj][m][1];
                    v0 = v0 * s0; v1 = v1 * s1;
                    u32x4 w; w.x = cvt_pk_bf16(v0[0], v0[1]); w.y = cvt_pk_bf16(v0[2], v0[3]); w.z = cvt_pk_bf16(v1[0], v1[1]); w.w = cvt_pk_bf16(v1[2], v1[3]);
                    *(u32x4*)rowp = w; } }
    }
};
struct EpiSwiGLU8 {
    static constexpr bool PERM = true, AFTER_DRAIN = false;
    unsigned char* O; int ldc; float insc, outsc;
    __device__ __forceinline__ void operator()(const f32x4 (&acc)[2][2][4][2], const Unit& u, int wr, int wc, int fr, int fq) const {
        const int row0 = u.pm * BM + wr * 64 + fr; const int col0 = u.pn * HALF + wc * 32 + 8 * fq;
        const float c1 = -insc * 1.4426950408889634f, c2 = insc * insc * outsc;
#pragma unroll
        for (int ai = 0; ai < 2; ++ai)
#pragma unroll
            for (int m = 0; m < 4; ++m) { unsigned char* rowp = O + (size_t)(row0 + ai * HALF + m * 16) * ldc + col0;
                float r[8];
#pragma unroll
                for (int n = 0; n < 2; ++n)
#pragma unroll
                    for (int j = 0; j < 4; ++j) { const float a0 = acc[ai][0][m][n][j], a1 = acc[ai][1][m][n][j];
                        r[n * 4 + j] = (a0 * a1) * c2 * __builtin_amdgcn_rcpf(1.0f + __builtin_amdgcn_exp2f(a0 * c1)); }
                u32x2 w; w.x = pk_fp8x4(r[0], r[1], r[2], r[3]); w.y = pk_fp8x4(r[4], r[5], r[6], r[7]);
                *(u32x2*)rowp = w; }
    }
};
typedef int i32x4 __attribute__((ext_vector_type(4)));
typedef int i32x8 __attribute__((ext_vector_type(8)));
template <class Epi, class Sched, bool ALIGN_EPI = false, bool SP2 = false, bool FP8 = false>
__device__ __forceinline__ void gemm_phase(PG8_LAS unsigned char* lds, const Gemm g, const Sched& S, const Epi& E, const int tid) {
    const int wid = __builtin_amdgcn_readfirstlane(tid >> 6), lane = tid & 63, wr = wid >> 2, wc = wid & 3, fr = lane & 15, fq = lane >> 4;
    const int K = g.K, nt = K / BK;
    unsigned voffA[2], voffB[2];
#pragma unroll
    for (int i = 0; i < 2; ++i) { int R, C; stage_rc(tid * 16 + i * 8192, R, C); const int Rb = Epi::PERM ? ((R & ~31) + perm32(R & 31)) : R;
        voffA[i] = (unsigned)(R * g.lda + C) * 2u; voffB[i] = (unsigned)(Rb * g.ldb + C) * 2u; }
    const size_t kstep = (size_t)(BK * 2);
    const size_t hstepA = (size_t)HALF * g.lda * 2, hstepB = (size_t)HALF * g.ldb * 2;
    const size_t tstepA = 2 * hstepA, tstepB = 2 * hstepB;
    const unsigned ldsw = (unsigned)wid * 1024u;
    const int aoff = lds_byte(wr * 64 + fr, fq * 8), boff = lds_byte(wc * 32 + fr, fq * 8);
#define PG8_SA(b, h) (((b) * 2 + (h)) * HTB)
#define PG8_SB(b, h) ((4 + (b) * 2 + (h)) * HTB)
#define PG8_STAGE(bufoff, gbase, voff) do { _Pragma("unroll") for (int _i = 0; _i < 2; ++_i) \
        __builtin_amdgcn_global_load_lds((const unsigned*)((const char*)(gbase) + (voff)[_i]), (PG8_LAS unsigned*)(lds + (bufoff) + ldsw + _i * 8192), 16, 0, 0); } while (0)
#define PG8_LDA(dst, b, h) do { if constexpr (FP8) { _Pragma("unroll") for (int m = 0; m < 4; ++m) dst##8[m] = __builtin_shufflevector(*(const PG8_LAS i32x4*)(lds + PG8_SA(b, h) + aoff + m * 2048), *(const PG8_LAS i32x4*)(lds + PG8_SA(b, h) + aoff + m * 2048 + 1024), 0, 1, 2, 3, 4, 5, 6, 7); } \
        else { _Pragma("unroll") for (int m = 0; m < 4; ++m) _Pragma("unroll") for (int k = 0; k < 2; ++k) dst[m][k] = *(const PG8_LAS bf16x8*)(lds + PG8_SA(b, h) + aoff + m * 2048 + k * 1024); } } while (0)
#define PG8_LDB(dst, b, h) do { if constexpr (FP8) { _Pragma("unroll") for (int n = 0; n < 2; ++n) dst##8[n] = __builtin_shufflevector(*(const PG8_LAS i32x4*)(lds + PG8_SB(b, h) + boff + n * 2048), *(const PG8_LAS i32x4*)(lds + PG8_SB(b, h) + boff + n * 2048 + 1024), 0, 1, 2, 3, 4, 5, 6, 7); } \
        else { _Pragma("unroll") for (int n = 0; n < 2; ++n) _Pragma("unroll") for (int k = 0; k < 2; ++k) dst[n][k] = *(const PG8_LAS bf16x8*)(lds + PG8_SB(b, h) + boff + n * 2048 + k * 1024); } } while (0)
#define PG8_MMA(ai, bj, At, Bt) do { __builtin_amdgcn_s_setprio(1); \
        if constexpr (FP8) { _Pragma("unroll") for (int m = 0; m < 4; ++m) _Pragma("unroll") for (int n = 0; n < 2; ++n) \
            asm volatile("v_mfma_f32_16x16x128_f8f6f4 %0, %1, %2, %0" : "+v"(acc[ai][bj][m][n]) : "v"(Bt##8[n]), "v"(At##8[m])); } \
        else { _Pragma("unroll") for (int m = 0; m < 4; ++m) _Pragma("unroll") for (int n = 0; n < 2; ++n) _Pragma("unroll") for (int k = 0; k < 2; ++k) \
            acc[ai][bj][m][n] = __builtin_amdgcn_mfma_f32_16x16x32_bf16(Bt[n][k], At[m][k], acc[ai][bj][m][n], 0, 0, 0); } \
        __builtin_amdgcn_s_setprio(0); } while (0)
#define PG8_WAIT_V(n) asm volatile("s_waitcnt vmcnt(" #n ")" ::: "memory")
#define PG8_WAIT_L(n) asm volatile("s_waitcnt lgkmcnt(" #n ")" ::: "memory")
#define PG8_BAR __builtin_amdgcn_s_barrier()
#define PG8_SCHED __builtin_amdgcn_sched_barrier(0)
    Unit cur, nxt; int ui = 0;
    if (!S.next(0, cur)) return;
    f32x4 acc[2][2][4][2];
#pragma unroll
    for (int a = 0; a < 2; ++a)
#pragma unroll
        for (int b = 0; b < 2; ++b)
#pragma unroll
            for (int m = 0; m < 4; ++m)
#pragma unroll
                for (int n = 0; n < 2; ++n) acc[a][b][m][n] = (f32x4){0.f, 0.f, 0.f, 0.f};
    bf16x8 At[4][2], B0[2][2], B1[2][2]; i32x8 At8[4], B08[2], B18[2]; (void)At; (void)B0; (void)B1; (void)At8; (void)B08; (void)B18;
    const char* cA = (const char*)g.A + (size_t)cur.pm * tstepA + (size_t)cur.pn * g.a_pn_off; const char* cB = (const char*)g.Bt + (size_t)cur.pn * tstepB;
    S.a_ready(cur);
    if constexpr (SP2) {
        PG8_STAGE(PG8_SB(0, 0), cB, voffB); PG8_STAGE(PG8_SB(0, 1), cB + hstepB, voffB); PG8_STAGE(PG8_SA(0, 0), cA, voffA); PG8_STAGE(PG8_SA(0, 1), cA + hstepA, voffA);
        if (wr == 1) PG8_BAR;
        PG8_WAIT_V(2); PG8_BAR;
        PG8_STAGE(PG8_SB(1, 0), cB + kstep, voffB); PG8_STAGE(PG8_SA(1, 0), cA + kstep, voffA); PG8_STAGE(PG8_SB(1, 1), cB + hstepB + kstep, voffB);
        PG8_WAIT_V(6); PG8_BAR;
    } else {
        PG8_STAGE(PG8_SB(0, 0), cB, voffB); PG8_STAGE(PG8_SA(0, 0), cA, voffA); PG8_STAGE(PG8_SB(0, 1), cB + hstepB, voffB); PG8_STAGE(PG8_SA(0, 1), cA + hstepA, voffA);
        if (wr == 1) PG8_BAR;
        PG8_WAIT_V(4); PG8_BAR;
        PG8_STAGE(PG8_SB(1, 0), cB + kstep, voffB); PG8_STAGE(PG8_SA(1, 0), cA + kstep, voffA); PG8_STAGE(PG8_SB(1, 1), cB + hstepB + kstep, voffB);
        PG8_WAIT_V(6); PG8_BAR;
    }
    for (;;) {
        const bool has_next = S.next(ui + 1, nxt);
        const char* nA = has_next ? (const char*)g.A + (size_t)nxt.pm * tstepA + (size_t)nxt.pn * g.a_pn_off : cA; const char* nB = has_next ? (const char*)g.Bt + (size_t)nxt.pn * tstepB : cB;
#pragma unroll 1
        for (int t = 0; t < nt; t += 2) {
            const bool last = (t == nt - 2);
            const char* a1 = cA + (size_t)(t + 1) * kstep;
            const char* a2 = last ? nA : cA + (size_t)(t + 2) * kstep; const char* b2 = last ? nB : cB + (size_t)(t + 2) * kstep;
            const char* a3 = a2 + kstep; const char* b3 = b2 + kstep;
            if (last && has_next) S.a_ready(nxt);
            if constexpr (SP2) {
            PG8_LDB(B0, 0, 0); PG8_LDB(B1, 0, 1); PG8_SCHED; PG8_LDA(At, 0, 0); PG8_STAGE(PG8_SA(1, 1), a1 + hstepA, voffA);
            PG8_WAIT_V(8); PG8_WAIT_L(0); PG8_BAR; PG8_MMA(0, 0, At, B0); PG8_MMA(0, 1, At, B1); PG8_BAR; PG8_SCHED;
            PG8_LDA(At, 0, 1); PG8_STAGE(PG8_SB(0, 0), b2, voffB); PG8_STAGE(PG8_SB(0, 1), b2 + hstepB, voffB); PG8_STAGE(PG8_SA(0, 0), a2, voffA);
            PG8_WAIT_V(8); PG8_WAIT_L(0); PG8_BAR; PG8_MMA(1, 0, At, B0); PG8_MMA(1, 1, At, B1); PG8_BAR; PG8_SCHED;
            PG8_LDB(B0, 1, 0); PG8_LDB(B1, 1, 1); PG8_SCHED; PG8_LDA(At, 1, 0); PG8_STAGE(PG8_SA(0, 1), a2 + hstepA, voffA);
            PG8_WAIT_V(8); PG8_WAIT_L(0); PG8_BAR; PG8_MMA(0, 0, At, B0); PG8_MMA(0, 1, At, B1); PG8_BAR; PG8_SCHED;
            PG8_LDA(At, 1, 1); PG8_STAGE(PG8_SB(1, 0), b3, voffB); PG8_STAGE(PG8_SB(1, 1), b3 + hstepB, voffB); PG8_STAGE(PG8_SA(1, 0), a3, voffA);
            PG8_WAIT_V(8); PG8_WAIT_L(0); PG8_BAR; PG8_MMA(1, 0, At, B0); PG8_MMA(1, 1, At, B1); PG8_BAR; PG8_SCHED;
            } else {
            PG8_LDB(B0, 0, 0); PG8_SCHED; PG8_LDA(At, 0, 0); PG8_STAGE(PG8_SA(1, 1), a1 + hstepA, voffA);
            PG8_WAIT_L(8); PG8_BAR; PG8_WAIT_L(0); PG8_MMA(0, 0, At, B0); PG8_BAR; PG8_SCHED;
            PG8_LDB(B1, 0, 1); PG8_STAGE(PG8_SB(0, 0), b2, voffB);
            PG8_BAR; PG8_WAIT_L(0); PG8_MMA(0, 1, At, B1); PG8_BAR;
            PG8_LDA(At, 0, 1); PG8_STAGE(PG8_SA(0, 0), a2, voffA);
            PG8_BAR; PG8_WAIT_L(0); PG8_MMA(1, 0, At, B0); PG8_BAR; PG8_SCHED;
            PG8_STAGE(PG8_SB(0, 1), b2 + hstepB, voffB);
            PG8_WAIT_V(6); PG8_BAR; PG8_MMA(1, 1, At, B1); PG8_BAR;
            PG8_LDB(B0, 1, 0); PG8_SCHED; PG8_LDA(At, 1, 0); PG8_STAGE(PG8_SA(0, 1), a2 + hstepA, voffA);
            PG8_WAIT_L(8); PG8_BAR; PG8_WAIT_L(0); PG8_MMA(0, 0, At, B0); PG8_BAR; PG8_SCHED;
            PG8_LDB(B1, 1, 1); PG8_STAGE(PG8_SB(1, 0), b3, voffB);
            PG8_BAR; PG8_WAIT_L(0); PG8_MMA(0, 1, At, B1); PG8_BAR;
            PG8_LDA(At, 1, 1); PG8_STAGE(PG8_SA(1, 0), a3, voffA);
            PG8_BAR; PG8_WAIT_L(0); PG8_MMA(1, 0, At, B0); PG8_BAR; PG8_SCHED;
            PG8_STAGE(PG8_SB(1, 1), b3 + hstepB, voffB);
            PG8_WAIT_V(6); PG8_BAR; PG8_MMA(1, 1, At, B1); PG8_BAR;
            }
        }
        if constexpr (ALIGN_EPI) { if (wr == 0) PG8_BAR; }
        if constexpr (FP8) { asm volatile("s_nop 15\n\ts_nop 15" ::: "memory"); __builtin_amdgcn_sched_barrier(0); }
        if constexpr (!Epi::AFTER_DRAIN) { E(acc, cur, wr, wc, fr, fq); S.done(cur); }
        if (!has_next) break;
#pragma unroll
        for (int a = 0; a < 2; ++a)
#pragma unroll
            for (int b = 0; b < 2; ++b)
#pragma unroll
                for (int m = 0; m < 4; ++m)
#pragma unroll
                    for (int n = 0; n < 2; ++n) acc[a][b][m][n] = (f32x4){0.f, 0.f, 0.f, 0.f};
        cur = nxt; cA = nA; cB = nB; ++ui;
        if constexpr (ALIGN_EPI) { if (wr == 1) PG8_BAR; }
    }
    PG8_WAIT_V(0);
    if constexpr (!ALIGN_EPI) { if (wr == 0) PG8_BAR; }
    PG8_BAR;
    if constexpr (Epi::AFTER_DRAIN) { E.fused(acc, cur, wr, wc, fr, fq, lds, wid, lane); S.done(cur); }
#undef PG8_SA
#undef PG8_SB
#undef PG8_STAGE
#undef PG8_LDA
#undef PG8_LDB
#undef PG8_MMA
#undef PG8_WAIT_V
#undef PG8_WAIT_L
#undef PG8_BAR
#undef PG8_SCHED
}
}

#define PG8_SP2 true
#define PG8_ALIGN true

#define XB_TMO      128
#define XB_XCNT(j)  (256  + 64 * (j))
#define XB_XSUB(j)  (1280 + 64 * (j))
#define XB_XGEN(j)  (2304 + 64 * (j))
#define XB_TOP      3328
#define XB_TOPGEN   3392
#define XCD_BAR_WORDS 3456
#define XB_SPIN_CAP (1u << 18)

__device__ __forceinline__ unsigned xb_ld(unsigned* p)              { return __hip_atomic_load(p, __ATOMIC_RELAXED, __HIP_MEMORY_SCOPE_AGENT); }
__device__ __forceinline__ unsigned xb_add(unsigned* p, unsigned v) { return __hip_atomic_fetch_add(p, v, __ATOMIC_RELAXED, __HIP_MEMORY_SCOPE_AGENT); }
__device__ __forceinline__ unsigned xb_xcc_id() { return (unsigned)__builtin_amdgcn_s_getreg((3 << 11) | 20) & 0xFu; }
#define XB_SPIN(cond, bar) do { unsigned _sp = 0; while (cond) { __builtin_amdgcn_s_sleep(1); \
    if ((++_sp & 255u) == 0u) { if (xb_ld(&(bar)[XB_TMO])) break; if (_sp > XB_SPIN_CAP) { atomicAdd(&(bar)[XB_TMO], 1u); break; } } } } while (0)

struct XcdBarrier {
    unsigned* bar; unsigned x;
    volatile LAS unsigned* st;
};
__device__ __forceinline__ XcdBarrier xcd_barrier_post(unsigned* bar, volatile LAS unsigned* st) {
    XcdBarrier b; b.bar = bar; b.x = xb_xcc_id(); b.st = st;
    if (threadIdx.x == 0) (void)xb_add(&bar[XB_XCNT(b.x)], 1u);
    return b;
}
__device__ __forceinline__ void xcd_barrier_complete(unsigned* bar, unsigned x, unsigned& nloc, unsigned& nx) {
    const unsigned G = gridDim.x * gridDim.y * gridDim.z;
    unsigned sum, cnt, mine, sp = 0u;
    for (;;) {
        sum = 0u; cnt = 0u; mine = 0u;
#pragma unroll
        for (unsigned j = 0; j < 16; ++j) { const unsigned c = xb_ld(&bar[XB_XCNT(j)]); sum += c; cnt += (c > 0u) ? 1u : 0u; mine = (j == x) ? c : mine; }
        if (sum == G) break;
        __builtin_amdgcn_s_sleep(1);
        if ((++sp & 255u) == 0u) { if (xb_ld(&bar[XB_TMO])) break; if (sp > XB_SPIN_CAP) { atomicAdd(&bar[XB_TMO], 1u); break; } }
    }
    nloc = mine > 0u ? mine : 1u; nx = cnt > 0u ? cnt : 1u;
}
__device__ __forceinline__ void xcd_barrier(const XcdBarrier& b) {
    asm volatile("s_waitcnt vmcnt(0)" ::: "memory");
    __syncthreads();
    if (threadIdx.x == 0) {
        unsigned* bar = b.bar;
        __builtin_amdgcn_s_waitcnt(0);
        unsigned nloc = b.st[0], nx = b.st[1];
        if (nloc == 0u) { xcd_barrier_complete(bar, b.x, nloc, nx); b.st[0] = nloc; b.st[1] = nx; }
        const unsigned old = xb_add(&bar[XB_XSUB(b.x)], 1u);
        const unsigned gen = old / nloc;
        if (old + 1u == (gen + 1u) * nloc) {
            __builtin_amdgcn_fence(__ATOMIC_RELEASE, "agent");
            asm volatile("s_waitcnt vmcnt(0)" ::: "memory");
            const unsigned og = xb_add(&bar[XB_TOP], 1u);
            const unsigned tg = og / nx;
            if (og + 1u == (tg + 1u) * nx) xb_add(&bar[XB_TOPGEN], 1u);
            else XB_SPIN(xb_ld(&bar[XB_TOPGEN]) == tg, bar);
            __builtin_amdgcn_fence(__ATOMIC_ACQUIRE, "agent");
            xb_add(&bar[XB_XGEN(b.x)], 1u);
            asm volatile("s_waitcnt vmcnt(0)" ::: "memory");
        } else {
            XB_SPIN(xb_ld(&bar[XB_XGEN(b.x)]) == gen, bar);
            __builtin_amdgcn_fence(__ATOMIC_ACQUIRE, "agent");
            asm volatile("s_waitcnt vmcnt(0)" ::: "memory");
        }
    }
    __syncthreads();
}

#define LDS_WAIT() asm volatile("s_waitcnt lgkmcnt(0)" ::: "memory")

__device__ __forceinline__ void transpose_item(const float* W, int K, int N, int k0, int n0, bf16_t* dst_row0, LAS float* scr, int lane) {
#pragma unroll 8
    for (int i = 0; i < 32; ++i) { const int kk = 2 * i + (lane >> 5); scr[kk * 33 + (lane & 31)] = W[(size_t)(k0 + kk) * N + n0 + (lane & 31)]; }
    LDS_WAIT(); asm volatile("" ::: "memory");
    const int c = lane & 7;
#pragma unroll
    for (int j = 0; j < 4; ++j) { const int n = (lane >> 3) + 8 * j; const LAS float* s = scr + (8 * c) * 33 + n;
        u32x4 o; o.x = pk2(s[0 * 33], s[1 * 33]); o.y = pk2(s[2 * 33], s[3 * 33]); o.z = pk2(s[4 * 33], s[5 * 33]); o.w = pk2(s[6 * 33], s[7 * 33]);
        *(u32x4*)(dst_row0 + (size_t)n * K + k0 + 8 * c) = o; }
    LDS_WAIT(); asm volatile("" ::: "memory");
}
__device__ __forceinline__ void transpose_item8(const float* W, int K, int N, int k0, int n0, unsigned char* dst_row0, float sc, LAS float* scr, int lane) {
#pragma unroll 8
    for (int i = 0; i < 32; ++i) { const int kk = 2 * i + (lane >> 5); scr[kk * 33 + (lane & 31)] = W[(size_t)(k0 + kk) * N + n0 + (lane & 31)]; }
    LDS_WAIT(); asm volatile("" ::: "memory");
    const int c = lane & 7;
#pragma unroll
    for (int j = 0; j < 4; ++j) { const int n = (lane >> 3) + 8 * j; const LAS float* s = scr + (8 * c) * 33 + n;
        u32x2 o; o.x = pg8::pk_fp8x4(s[0 * 33] * sc, s[1 * 33] * sc, s[2 * 33] * sc, s[3 * 33] * sc); o.y = pg8::pk_fp8x4(s[4 * 33] * sc, s[5 * 33] * sc, s[6 * 33] * sc, s[7 * 33] * sc);
        *(u32x2*)(dst_row0 + (size_t)n * K + k0 + 8 * c) = o; }
    LDS_WAIT(); asm volatile("" ::: "memory");
}
constexpr float SC_H8 = 8.0f, SC_WGU8 = 128.0f, SC_ACT8 = 8.0f, SC_WDN8 = 512.0f, SC_WIN8 = 128.0f, SC_MIX8 = 8.0f, SC_WOUT8 = 256.0f;
constexpr int IT_IN = (D / 64) * (INW / 32), IT_OUT = (D / 64) * (D / 32), IT_GU = (D / 64) * (NGU / 32), IT_DN = (DFF / 64) * (D / 32), IT_POOL = 4 * (256 / 64) * (256 / 32);
constexpr int IT_LAYER = IT_IN + IT_OUT + IT_GU + IT_DN + IT_POOL;
__device__ __forceinline__ void convert_weights(const float* w_in, const float* w_out, const float* w_gu, const float* w_down, const float* w_pool, unsigned char* ws, LAS unsigned char* lds, int wave, int lane) {
    LAS float* scr = (LAS float*)(lds + wave * 16384);
    const int gw = blockIdx.x * 8 + wave, NGW = gridDim.x * 8;
    for (int it = gw; it < DEPTH * IT_LAYER; it += NGW) {
        const int l = it / IT_LAYER; int r = it % IT_LAYER;
        if (r < IT_IN) { const int nblk = INW / 32, kb = r / nblk, nb = r % nblk, n0 = nb * 32;
            const float* src = w_in + (size_t)l * D * INW;
            if (n0 < 2048) { transpose_item(src, D, INW, kb * 64, n0, (bf16_t*)(ws + WS_WIN) + ((size_t)l * NZ + n0) * D, scr, lane);
                transpose_item8(src, D, INW, kb * 64, n0, (unsigned char*)(ws + WS_WIN8) + ((size_t)l * NZ + n0) * D, SC_WIN8, scr, lane); }
            else if (n0 < 3072) transpose_item8(src, D, INW, kb * 64, n0, (unsigned char*)(ws + WS_WIN8) + ((size_t)l * NZ + n0) * D, SC_WIN8, scr, lane);
            else if (n0 < 3104) transpose_item(src, D, INW, kb * 64, n0, (bf16_t*)(ws + WS_WG) + ((size_t)l * 32) * D, scr, lane);
            else transpose_item8(src, D, INW, kb * 64, n0, (unsigned char*)(ws + WS_WIN8) + ((size_t)l * NZ + n0 - 32) * D, SC_WIN8, scr, lane);
            continue; }
        r -= IT_IN;
        if (r < IT_OUT) { const int nblk = D / 32, kb = r / nblk, nb = r % nblk, n0 = nb * 32;
            transpose_item8(w_out + (size_t)l * D * D, D, D, kb * 64, n0, (unsigned char*)(ws + WS_WOUT) + ((size_t)l * D + n0) * D, SC_WOUT8, scr, lane); continue; }
        r -= IT_OUT;
        if (r < IT_GU) { const int nblk = NGU / 32, kb = r / nblk, nb = r % nblk, n0 = nb * 32;
            const int up = n0 >= DFF ? 1 : 0, j = n0 - up * DFF, drow = 256 * (j >> 7) + 128 * up + (j & 127);
            transpose_item8(w_gu + (size_t)l * D * NGU, D, NGU, kb * 64, n0, (unsigned char*)(ws + WS_WGU) + ((size_t)l * NGU + drow) * D, SC_WGU8, scr, lane); continue; }
        r -= IT_GU;
        if (r < IT_DN) { const int nblk = D / 32, kb = r / nblk, nb = r % nblk, n0 = nb * 32;
            transpose_item8(w_down + (size_t)l * DFF * D, DFF, D, kb * 64, n0, (unsigned char*)(ws + WS_WDN) + ((size_t)l * D + n0) * DFF, SC_WDN8, scr, lane); continue; }
        r -= IT_DN;
        { const int g = r >> 5, rr = r & 31, kb = rr >> 3, nb = rr & 7, n0 = nb * 32;
            transpose_item(w_pool + ((size_t)l * 4 + g) * 65536, 256, 256, kb * 64, n0, (bf16_t*)(ws + WS_WPOOL) + ((size_t)(l * 4 + g) * 256 + n0) * 256, scr, lane); }
    }
}
__device__ __forceinline__ void compute_mods(const float* c, const float* c_ctx, const float* w_ada, const float* b_ada, float* MODS, LAS unsigned char* lds, int tid, int wave, int lane) {
    LAS float* st = (LAS float*)lds;
    LAS float* red = (LAS float*)(lds + NMOD * D * 4);
    for (int idx = tid; idx < NMOD * D; idx += 512) { const int i = idx / D, k = idx % D; const float v = (i < 8) ? c[i * D + k] : c_ctx[k]; st[idx] = silu_f(v); }
    __syncthreads();
    for (int unit = blockIdx.x; unit < DEPTH * (MODW / 64); unit += gridDim.x) {
        const int l = unit / (MODW / 64), n0 = (unit % (MODW / 64)) * 64;
        f32x4 acc[NMOD];
#pragma unroll
        for (int i = 0; i < NMOD; ++i) acc[i] = (f32x4){0.f, 0.f, 0.f, 0.f};
        const float* wp = w_ada + ((size_t)l * D + wave * 256 + (lane >> 4)) * MODW + n0 + 4 * (lane & 15);
#pragma unroll 4
        for (int it = 0; it < 64; ++it) {
            const f32x4 wv = *(const f32x4*)(wp + (size_t)it * 4 * MODW);
            const int k = wave * 256 + it * 4 + (lane >> 4);
#pragma unroll
            for (int i = 0; i < NMOD; ++i) { const float s = st[i * D + k]; acc[i] += wv * s; }
        }
#pragma unroll
        for (int i = 0; i < NMOD; ++i) {
#pragma unroll
            for (int j = 0; j < 4; ++j) { float v = acc[i][j]; v += __shfl_xor(v, 16); v += __shfl_xor(v, 32); acc[i][j] = v; }
            if (lane < 16) *(LAS f32x4*)(red + (wave * NMOD + i) * 64 + 4 * lane) = acc[i];
        }
        __syncthreads();
        for (int idx = tid; idx < NMOD * 64; idx += 512) { const int i = idx >> 6, cc = idx & 63; float s = b_ada[(size_t)l * MODW + n0 + cc];
#pragma unroll
            for (int w = 0; w < 8; ++w) s += red[(w * NMOD + i) * 64 + cc];
            MODS[((size_t)l * NMOD + i) * MODW + n0 + cc] = s; }
        __syncthreads();
    }
}

template <int MODE, int HFMT>
__device__ __forceinline__ void ln_row(const u32x4 (&xr)[4], const u32x4 (&mr)[4], const f32x4 (&xf)[8], int row, bf16_t* X, bf16_t* H, unsigned char* H8, float* OUT, bool write_h,
                                       const LAS float* Vg, const LAS float* Vn, const LAS float* Vb, const LAS float* Vc, const LAS float* Vs, int lane) {
    float v[32]; float s = 0.f;
#pragma unroll
    for (int j = 0; j < 4; ++j) { const int col = 8 * lane + 512 * j;
        if (MODE == 1) { const f32x4 g0 = *(const LAS f32x4*)(Vg + col), g1 = *(const LAS f32x4*)(Vg + col + 4);
            const unsigned xw[4] = {xr[j].x, xr[j].y, xr[j].z, xr[j].w}, mw[4] = {mr[j].x, mr[j].y, mr[j].z, mr[j].w};
#pragma unroll
            for (int e = 0; e < 4; ++e) { const float ga = e < 2 ? g0[2 * e] : g1[2 * e - 4], gb = e < 2 ? g0[2 * e + 1] : g1[2 * e - 3];
                v[8 * j + 2 * e] = h2lo(xw[e]) * ALPHA + ga * bflo(mw[e]); v[8 * j + 2 * e + 1] = h2hi(xw[e]) * ALPHA + gb * bfhi(mw[e]); } }
        else {
#pragma unroll
            for (int e = 0; e < 4; ++e) { v[8 * j + e] = xf[2 * j][e]; v[8 * j + 4 + e] = xf[2 * j + 1][e]; } }
#pragma unroll
        for (int e = 0; e < 8; e += 2) s += v[8 * j + e] + v[8 * j + e + 1]; }
    const float mean = wave_sum(s) * (1.f / D); float s2 = 0.f;
#pragma unroll
    for (int i = 0; i < 32; ++i) { v[i] -= mean; s2 += v[i] * v[i]; }
    const float rstd = 1.f / sqrtf(wave_sum(s2) * (1.f / D) + LN_EPS);
#pragma unroll
    for (int j = 0; j < 4; ++j) { const int col = 8 * lane + 512 * j;
        const f32x4 n0 = *(const LAS f32x4*)(Vn + col), n1 = *(const LAS f32x4*)(Vn + col + 4), b0 = *(const LAS f32x4*)(Vb + col), b1 = *(const LAS f32x4*)(Vb + col + 4);
        float y[8];
#pragma unroll
        for (int e = 0; e < 8; ++e) y[e] = v[8 * j + e] * rstd * (e < 4 ? n0[e] : n1[e - 4]) + (e < 4 ? b0[e] : b1[e - 4]);
        if (OUT) { *(f32x4*)(OUT + (size_t)row * D + col) = (f32x4){y[0], y[1], y[2], y[3]}; *(f32x4*)(OUT + (size_t)row * D + col + 4) = (f32x4){y[4], y[5], y[6], y[7]}; }
        else { u32x4 w; w.x = pkh2(y[0], y[1]); w.y = pkh2(y[2], y[3]); w.z = pkh2(y[4], y[5]); w.w = pkh2(y[6], y[7]); *(u32x4*)(X + (size_t)row * D + col) = w; }
        if (write_h) { const f32x4 c0 = *(const LAS f32x4*)(Vc + col), c1 = *(const LAS f32x4*)(Vc + col + 4), h0 = *(const LAS f32x4*)(Vs + col), h1 = *(const LAS f32x4*)(Vs + col + 4);
            float h[8];
#pragma unroll
            for (int e = 0; e < 8; ++e) h[e] = y[e] * (e < 4 ? c0[e] : c1[e - 4]) + (e < 4 ? h0[e] : h1[e - 4]);
            if (HFMT == 0 || HFMT == 2) { u32x4 w; w.x = pg8::cvt_pk_bf16(h[0], h[1]); w.y = pg8::cvt_pk_bf16(h[2], h[3]); w.z = pg8::cvt_pk_bf16(h[4], h[5]); w.w = pg8::cvt_pk_bf16(h[6], h[7]); *(u32x4*)(H + (size_t)row * D + col) = w; }
            if (HFMT == 1 || HFMT == 2) { u32x2 w; w.x = pg8::pk_fp8x4(h[0] * SC_H8, h[1] * SC_H8, h[2] * SC_H8, h[3] * SC_H8); w.y = pg8::pk_fp8x4(h[4] * SC_H8, h[5] * SC_H8, h[6] * SC_H8, h[7] * SC_H8);
                *(u32x2*)(H8 + (size_t)row * D + col) = w; } }
        __builtin_amdgcn_sched_barrier(0); }
}
template <int MODE, int HFMT>
__device__ __forceinline__ void ln_phase(const float* xp, const float* xs, bf16_t* X, const bf16_t* MB, bf16_t* H, unsigned char* H8, float* OUT,
                                         const float* lng, const float* lnb, const float* modg, int goff, const float* modh, int shoff, int scoff, bool write_h,
                                         LAS unsigned char* lds, int tid, int wave, int lane) {
    LAS float* Vg = (LAS float*)lds;
    LAS float* Vn = Vg + D;
    LAS float* Vb = Vn + D;
    LAS float* Vc = Vb + D;
    LAS float* Vs = Vc + D;
    for (int grp = blockIdx.x; grp < MT / 32; grp += gridDim.x) {
        const int row0 = grp * 32, mi = row0 < MP ? 8 : ((row0 - MP) >> 11);
        { const int col = tid * 4;
          if (MODE == 1) *(LAS f32x4*)(Vg + col) = *(const f32x4*)(modg + (size_t)mi * MODW + goff + col);
          *(LAS f32x4*)(Vn + col) = *(const f32x4*)(lng + col); *(LAS f32x4*)(Vb + col) = *(const f32x4*)(lnb + col);
          if (write_h) { *(LAS f32x4*)(Vc + col) = *(const f32x4*)(modh + (size_t)mi * MODW + scoff + col) + 1.0f; *(LAS f32x4*)(Vs + col) = *(const f32x4*)(modh + (size_t)mi * MODW + shoff + col); } }
        const int r0 = row0 + wave * 4;
        if (MODE == 1) {
            u32x4 xr[4][4], mr[4][4];
#pragma unroll
            for (int k = 0; k < 4; ++k)
#pragma unroll
                for (int j = 0; j < 4; ++j) { xr[k][j] = *(const u32x4*)(X + (size_t)(r0 + k) * D + 8 * lane + 512 * j); mr[k][j] = *(const u32x4*)(MB + (size_t)(r0 + k) * D + 8 * lane + 512 * j); }
            __syncthreads();
            const f32x4 dummy[8] = {};
#pragma unroll
            for (int k = 0; k < 4; ++k) { ln_row<MODE, HFMT>(xr[k], mr[k], dummy, r0 + k, X, H, H8, OUT, write_h, Vg, Vn, Vb, Vc, Vs, lane); __builtin_amdgcn_sched_barrier(0); }
        } else {
            __syncthreads();
            const u32x4 dummy[4] = {};
#pragma unroll 1
            for (int kp = 0; kp < 2; ++kp) {
                f32x4 xf[2][8];
#pragma unroll
                for (int k = 0; k < 2; ++k) { const int row = r0 + 2 * kp + k; const float* src = row < MP ? xp + (size_t)row * D : xs + (size_t)(row - MP) * D;
#pragma unroll
                    for (int j = 0; j < 4; ++j) { xf[k][2 * j] = *(const f32x4*)(src + 8 * lane + 512 * j); xf[k][2 * j + 1] = *(const f32x4*)(src + 8 * lane + 512 * j + 4); } }
#pragma unroll
                for (int k = 0; k < 2; ++k) { ln_row<MODE, HFMT>(dummy, dummy, xf[k], r0 + 2 * kp + k, X, H, H8, OUT, write_h, Vg, Vn, Vb, Vc, Vs, lane); __builtin_amdgcn_sched_barrier(0); }
            }
        }
        __syncthreads();
    }
}

__device__ __forceinline__ void gates_gemm(const bf16_t* H, const bf16_t* Wg, float* GATES, int wave, int lane) {
    const int gw = blockIdx.x * 8 + wave, NGW = gridDim.x * 8, c = lane & 15, g = lane >> 4;
    for (int task = gw; task < MT / 16; task += NGW) {
        const int row0 = task * 16;
        f32x4 a0 = {0.f, 0.f, 0.f, 0.f}, a1 = {0.f, 0.f, 0.f, 0.f};
        const bf16_t* ap = H + (size_t)(row0 + c) * D + 8 * g; const bf16_t* b0 = Wg + (size_t)c * D + 8 * g; const bf16_t* b1 = Wg + (size_t)(16 + c) * D + 8 * g;
#pragma unroll 1
        for (int kb = 0; kb < D / 256; ++kb) {
            bf16x8 av[8], bv0[8], bv1[8];
#pragma unroll
            for (int ks = 0; ks < 8; ++ks) { av[ks] = *(const bf16x8*)(ap + kb * 256 + ks * 32); bv0[ks] = *(const bf16x8*)(b0 + kb * 256 + ks * 32); bv1[ks] = *(const bf16x8*)(b1 + kb * 256 + ks * 32); }
            __builtin_amdgcn_sched_barrier(0);
#pragma unroll
            for (int ks = 0; ks < 8; ++ks) { a0 = __builtin_amdgcn_mfma_f32_16x16x32_bf16(av[ks], bv0[ks], a0, 0, 0, 0); a1 = __builtin_amdgcn_mfma_f32_16x16x32_bf16(av[ks], bv1[ks], a1, 0, 0, 0); }
        }
#pragma unroll
        for (int r = 0; r < 4; ++r) { GATES[(size_t)(row0 + 4 * g + r) * 32 + c] = a0[r]; GATES[(size_t)(row0 + 4 * g + r) * 32 + 16 + c] = a1[r]; }
    }
}

__device__ __forceinline__ void gla_prep_unit(int u2, int l, const bf16_t* Z, const float* GATES, const float* w_a2, const float* b_a,
                                              bf16_t* QE, bf16_t* KDT, bf16_t* AM, float* DEC, LAS unsigned char* lds, int tid, int wave, int lane) {
    const int cg = u2 >> 2, h = u2 & 3, row0 = cg * 64;
    const int dir = tid >> 8, d = tid & 127, pg = (tid >> 7) & 1;
    const size_t u = (size_t)u2 * 2 + dir;
    LAS bf16_t* Rq = (LAS bf16_t*)lds;
    LAS bf16_t* Rk = (LAS bf16_t*)(lds + 17408);
    LAS bf16_t* Lq = (LAS bf16_t*)(lds + 34816 + dir * 34816);
    LAS bf16_t* Lk = Lq + 64 * 136;
    LAS float* La = (LAS float*)(lds + 104448);
    LAS float* Lt = (LAS float*)(lds + 104448 + 8192);
    { const int i = tid >> 3, part = tid & 7; *(LAS f32x4*)(La + i * 32 + part * 4) = *(const f32x4*)(GATES + (size_t)(row0 + i) * 32 + part * 4); }
#pragma unroll
    for (int k = 0; k < 2; ++k) { const int pc = tid + 512 * k, row = pc >> 4, part = pc & 15; const bf16_t* zp = Z + (size_t)(row0 + row) * NZ + h * DK + part * 8;
        *(LAS u32x4*)(Rq + row * 136 + part * 8) = *(const u32x4*)zp; *(LAS u32x4*)(Rk + row * 136 + part * 8) = *(const u32x4*)(zp + KW); }
    float w[16];
#pragma unroll
    for (int r = 0; r < 16; ++r) w[r] = w_a2[((size_t)(l * 2 + dir) * 16 + r) * KW + h * DK + d];
    const float bias = b_a[(size_t)(l * 2 + dir) * KW + h * DK + d];
    __syncthreads();
    float cs[32];
#pragma unroll
    for (int ii = 0; ii < 32; ++ii) { const int i = pg * 32 + ii; float x = bias;
#pragma unroll
        for (int r4 = 0; r4 < 4; ++r4) { const f32x4 a = *(const LAS f32x4*)(La + i * 32 + dir * 16 + r4 * 4); x += a[0] * w[r4 * 4] + a[1] * w[r4 * 4 + 1] + a[2] * w[r4 * 4 + 2] + a[3] * w[r4 * 4 + 3]; }
        const float ls = fminf(x, 0.f) - __logf(1.0f + __expf(-fabsf(x)));
        cs[ii] = ls * (1.0f / 16.0f); }
    float run = 0.f;
    if (dir == 0) {
#pragma unroll
        for (int ii = 0; ii < 32; ++ii) { run += cs[ii]; cs[ii] = run; }
    } else {
#pragma unroll
        for (int ii = 31; ii >= 0; --ii) { run += cs[ii]; cs[ii] = run; }
    }
    Lt[(dir * 2 + pg) * 128 + d] = run;
    __syncthreads();
    const float t0 = Lt[(dir * 2) * 128 + d], t1 = Lt[(dir * 2 + 1) * 128 + d];
    const float blast = t0 + t1;
    const float off = dir == 0 ? (pg == 1 ? t0 : 0.f) : (pg == 0 ? t1 : 0.f);
    const float elast = __expf(blast);
    unsigned kdw[16];
#pragma unroll
    for (int ii = 0; ii < 32; ii += 2) { const int i = pg * 32 + ii;
        const float b0 = off + cs[ii], b1 = off + cs[ii + 1];
        const float q0 = bf2f(Rq[i * 136 + d]), k0 = bf2f(Rk[i * 136 + d]), q1 = bf2f(Rq[(i + 1) * 136 + d]), k1 = bf2f(Rk[(i + 1) * 136 + d]);
        const float e0 = __expf(b0), e1 = __expf(b1), ke0 = k0 * __builtin_amdgcn_rcpf(e0), ke1 = k1 * __builtin_amdgcn_rcpf(e1);
        const unsigned qe = pg8::cvt_pk_bf16(q0 * QSCALE * e0, q1 * QSCALE * e1), ke = pg8::cvt_pk_bf16(ke0, ke1);
        kdw[ii >> 1] = pg8::cvt_pk_bf16(ke0 * elast, ke1 * elast);
        Lq[i * 136 + d] = (bf16_t)(qe & 0xffffu); Lq[(i + 1) * 136 + d] = (bf16_t)(qe >> 16);
        Lk[i * 136 + d] = (bf16_t)(ke & 0xffffu); Lk[(i + 1) * 136 + d] = (bf16_t)(ke >> 16); }
    { u32x4* kp = (u32x4*)(KDT + u * 8192 + d * 64 + pg * 32);
#pragma unroll
      for (int k = 0; k < 4; ++k) kp[k] = (u32x4){kdw[4 * k], kdw[4 * k + 1], kdw[4 * k + 2], kdw[4 * k + 3]}; }
    if (pg == 0) DEC[u * 128 + d] = elast;
    __syncthreads();
    { const int t2 = tid & 255;
#pragma unroll
      for (int k = 0; k < 4; ++k) { const int pc = t2 + 256 * k, row = pc >> 4, part = pc & 15; *(u32x4*)(QE + u * 8192 + row * 128 + part * 8) = *(const LAS u32x4*)(Lq + row * 136 + part * 8); } }
    const int c = lane & 15, g = lane >> 4;
#pragma unroll
    for (int tt = 0; tt < 4; ++tt) { const int T = (wave & 3) * 4 + tt, ti = T >> 2, tj = T & 3;
        f32x4 acc = {0.f, 0.f, 0.f, 0.f};
#pragma unroll
        for (int ks = 0; ks < 4; ++ks) { const bf16x8 a = *(const LAS bf16x8*)(Lq + (16 * ti + c) * 136 + 32 * ks + 8 * g), b = *(const LAS bf16x8*)(Lk + (16 * tj + c) * 136 + 32 * ks + 8 * g);
            acc = __builtin_amdgcn_mfma_f32_16x16x32_bf16(a, b, acc, 0, 0, 0); }
#pragma unroll
        for (int r = 0; r < 4; ++r) { const int i = 16 * ti + 4 * g + r, j = 16 * tj + c; const bool keep = dir == 0 ? (j <= i) : (j >= i);
            AM[u * 4096 + i * 64 + j] = (bf16_t)f2bf(keep ? acc[r] : 0.f); } }
    __syncthreads();
}

typedef short v4i16_t __attribute__((ext_vector_type(4)));
__device__ __forceinline__ s16x4 trrd(const LAS unsigned char* p) { return __builtin_bit_cast(s16x4, __builtin_amdgcn_ds_read_tr16_b64_v4i16((LAS v4i16_t*)p)); }
constexpr int SC_QE = 0, SC_KDT = 17408, SC_AM = 35840, SC_V = 45056, SC_DEC = 62464, SC_OST = 62976;
struct ScanRegs { u32x4 qe[2], kdt[2], am, v[2]; f32x4 dec; };
__device__ __forceinline__ void scan_fetch(ScanRegs& R, const bf16_t* Z, const bf16_t* QE, const bf16_t* KDT, const bf16_t* AM, const float* DEC, size_t u, int trow, int h, int half, int tid) {
#pragma unroll
    for (int k = 0; k < 2; ++k) { const int pc = tid + 512 * k; R.qe[k] = *(const u32x4*)(QE + u * 8192 + (pc >> 4) * 128 + (pc & 15) * 8); R.kdt[k] = *(const u32x4*)(KDT + u * 8192 + (pc >> 3) * 64 + (pc & 7) * 8);
        R.v[k] = *(const u32x4*)(Z + (size_t)(trow + (pc >> 4)) * NZ + 2 * KW + h * DV + half * 128 + (pc & 15) * 8); }
    R.am = *(const u32x4*)(AM + u * 4096 + (tid >> 3) * 64 + (tid & 7) * 8);
    R.dec = *(const f32x4*)(DEC + u * 128 + (tid & 31) * 4);
}
__device__ __forceinline__ void scan_commit(const ScanRegs& R, LAS unsigned char* lds, int tid) {
#pragma unroll
    for (int k = 0; k < 2; ++k) { const int pc = tid + 512 * k; *(LAS u32x4*)(lds + SC_QE + (pc >> 4) * 272 + (pc & 15) * 16) = R.qe[k]; *(LAS u32x4*)(lds + SC_KDT + (pc >> 3) * 144 + (pc & 7) * 16) = R.kdt[k];
        *(LAS u32x4*)(lds + SC_V + (pc >> 4) * 272 + (pc & 15) * 16) = R.v[k]; }
    *(LAS u32x4*)(lds + SC_AM + (tid >> 3) * 144 + (tid & 7) * 16) = R.am;
    if (tid < 32) *(LAS f32x4*)(lds + SC_DEC + tid * 16) = R.dec;
}
__device__ __forceinline__ void gla_scan_chain(int hchain, int l, const bf16_t* Z, const bf16_t* QE, const bf16_t* KDT, const bf16_t* AM, const float* DEC,
                                               const float* state_in, float* state_out, bf16_t* OF, bf16_t* OB, LAS unsigned char* lds, int tid, int wave, int lane) {
    const int half = hchain & 1, chain = hchain >> 1; const bool samp = chain < 64; const int id = samp ? chain : chain - 64;
    const int b = id >> 3, h = (id >> 1) & 3, dir = id & 1;
    const int rowbase = samp ? MP + b * L_S : b * L_P, nch = samp ? L_S / 64 : L_P / 64;
    bf16_t* O = dir == 0 ? OF : OB;
    const int c = lane & 15, g = lane >> 4, q = c >> 2, p = c & 3;
    const int col0 = half * 128 + 16 * wave + c;
    f32x4 S[8];
    if (samp) { const float* sp = state_in + ((size_t)((l * 2 + dir) * NB_S + b) * GH + h) * (DK * DV) + col0;
#pragma unroll
        for (int rt = 0; rt < 8; ++rt)
#pragma unroll
            for (int r = 0; r < 4; ++r) S[rt][r] = sp[(size_t)(16 * rt + 4 * g + r) * DV];
    } else {
#pragma unroll
        for (int rt = 0; rt < 8; ++rt) S[rt] = (f32x4){0.f, 0.f, 0.f, 0.f};
    }
    ScanRegs R;
    { const int ci0 = dir == 0 ? 0 : nch - 1; const int trow0 = rowbase + ci0 * 64;
      scan_fetch(R, Z, QE, KDT, AM, DEC, ((size_t)(trow0 >> 6) * GH + h) * 2 + dir, trow0, h, half, tid); }
    scan_commit(R, lds, tid);
    __syncthreads();
#pragma unroll 1
    for (int step = 0; step < nch; ++step) {
        const int ci = dir == 0 ? step : nch - 1 - step;
        const int trow = rowbase + ci * 64;
        if (step + 1 < nch) { const int cin = dir == 0 ? ci + 1 : ci - 1; const int trn = rowbase + cin * 64;
            scan_fetch(R, Z, QE, KDT, AM, DEC, ((size_t)(trn >> 6) * GH + h) * 2 + dir, trn, h, half, tid); }
#define SCQ(rt, ks, hf) (*(const LAS u32x2*)(lds + SC_QE + (16 * (rt) + c) * 272 + (32 * (ks) + 4 * g) * 2 + 32 * (hf)))
#define SCA(rt, ks) (*(const LAS bf16x8*)(lds + SC_AM + (16 * (rt) + c) * 144 + (32 * (ks) + 8 * g) * 2))
#define SCK(rt, ks) (*(const LAS bf16x8*)(lds + SC_KDT + (16 * (rt) + c) * 144 + (32 * (ks) + 8 * g) * 2))
#define SB0() __builtin_amdgcn_sched_barrier(0)
        bf16x8 Vb[2];
        u32x2 qa[2][4][2], qb[2][4][2];
#pragma unroll
        for (int ks = 0; ks < 2; ++ks) { const LAS unsigned char* vp = lds + SC_V + (32 * ks + 8 * g + q) * 272 + (16 * wave + 4 * p) * 2;
            const s16x4 lo = trrd(vp), hi = trrd(vp + 4 * 272);
            Vb[ks] = (bf16x8){lo[0], lo[1], lo[2], lo[3], hi[0], hi[1], hi[2], hi[3]}; }
#pragma unroll
        for (int ks = 0; ks < 2; ++ks)
#pragma unroll
            for (int rt = 0; rt < 4; ++rt) { qa[ks][rt][0] = SCQ(rt, ks, 0); qa[ks][rt][1] = SCQ(rt, ks, 1); }
        SB0();
        f32x4 o[4];
#pragma unroll
        for (int rt = 0; rt < 4; ++rt) o[rt] = (f32x4){0.f, 0.f, 0.f, 0.f};
#pragma unroll
        for (int ks = 0; ks < 2; ++ks)
#pragma unroll
            for (int rt = 0; rt < 4; ++rt) { qb[ks][rt][0] = SCQ(rt, ks + 2, 0); qb[ks][rt][1] = SCQ(rt, ks + 2, 1); }
#pragma unroll
        for (int ks = 0; ks < 2; ++ks) { const f32x4 lo = S[2 * ks], hi = S[2 * ks + 1];
            u32x4 sw; sw.x = pg8::cvt_pk_bf16(lo[0], lo[1]); sw.y = pg8::cvt_pk_bf16(lo[2], lo[3]); sw.z = pg8::cvt_pk_bf16(hi[0], hi[1]); sw.w = pg8::cvt_pk_bf16(hi[2], hi[3]);
            const bf16x8 Sb = __builtin_bit_cast(bf16x8, sw);
#pragma unroll
            for (int rt = 0; rt < 4; ++rt) o[rt] = __builtin_amdgcn_mfma_f32_16x16x32_bf16(__builtin_bit_cast(bf16x8, ((u32x4){qa[ks][rt][0].x, qa[ks][rt][0].y, qa[ks][rt][1].x, qa[ks][rt][1].y})), Sb, o[rt], 0, 0, 0); }
        SB0();
        bf16x8 fa[4][2];
#pragma unroll
        for (int rt = 0; rt < 4; ++rt) { fa[rt][0] = SCA(rt, 0); fa[rt][1] = SCA(rt, 1); }
#pragma unroll
        for (int ks = 0; ks < 2; ++ks) { const f32x4 lo = S[2 * ks + 4], hi = S[2 * ks + 5];
            u32x4 sw; sw.x = pg8::cvt_pk_bf16(lo[0], lo[1]); sw.y = pg8::cvt_pk_bf16(lo[2], lo[3]); sw.z = pg8::cvt_pk_bf16(hi[0], hi[1]); sw.w = pg8::cvt_pk_bf16(hi[2], hi[3]);
            const bf16x8 Sb = __builtin_bit_cast(bf16x8, sw);
#pragma unroll
            for (int rt = 0; rt < 4; ++rt) o[rt] = __builtin_amdgcn_mfma_f32_16x16x32_bf16(__builtin_bit_cast(bf16x8, ((u32x4){qb[ks][rt][0].x, qb[ks][rt][0].y, qb[ks][rt][1].x, qb[ks][rt][1].y})), Sb, o[rt], 0, 0, 0); }
        SB0();
        bf16x8 fk[4][2];
#pragma unroll
        for (int rt = 0; rt < 4; ++rt) { fk[rt][0] = SCK(rt, 0); fk[rt][1] = SCK(rt, 1); }
#pragma unroll
        for (int rt = 0; rt < 4; ++rt) {
            o[rt] = __builtin_amdgcn_mfma_f32_16x16x32_bf16(fa[rt][0], Vb[0], o[rt], 0, 0, 0);
            o[rt] = __builtin_amdgcn_mfma_f32_16x16x32_bf16(fa[rt][1], Vb[1], o[rt], 0, 0, 0); }
#pragma unroll
        for (int rt = 0; rt < 4; ++rt)
#pragma unroll
            for (int r = 0; r < 4; ++r) *(LAS bf16_t*)(lds + SC_OST + (16 * rt + 4 * g + r) * 272 + (16 * wave + c) * 2) = (bf16_t)f2bf(o[rt][r]);
        SB0();
        bf16x8 fk2[4][2];
#pragma unroll
        for (int rt = 0; rt < 4; ++rt) { fk2[rt][0] = SCK(rt + 4, 0); fk2[rt][1] = SCK(rt + 4, 1); }
#pragma unroll
        for (int rt = 0; rt < 4; ++rt) { S[rt] = S[rt] * *(const LAS f32x4*)(lds + SC_DEC + (16 * rt + 4 * g) * 4);
            S[rt] = __builtin_amdgcn_mfma_f32_16x16x32_bf16(fk[rt][0], Vb[0], S[rt], 0, 0, 0);
            S[rt] = __builtin_amdgcn_mfma_f32_16x16x32_bf16(fk[rt][1], Vb[1], S[rt], 0, 0, 0); }
        SB0();
#pragma unroll
        for (int rt = 4; rt < 8; ++rt) { S[rt] = S[rt] * *(const LAS f32x4*)(lds + SC_DEC + (16 * rt + 4 * g) * 4);
            S[rt] = __builtin_amdgcn_mfma_f32_16x16x32_bf16(fk2[rt - 4][0], Vb[0], S[rt], 0, 0, 0);
            S[rt] = __builtin_amdgcn_mfma_f32_16x16x32_bf16(fk2[rt - 4][1], Vb[1], S[rt], 0, 0, 0); }
#undef SCQ
#undef SCA
#undef SCK
#undef SB0
        __syncthreads();
#pragma unroll
        for (int k = 0; k < 2; ++k) { const int pc = tid + 512 * k, row = pc >> 4, part = pc & 15;
            *(u32x4*)(O + (size_t)(trow + row) * GW + h * DV + half * 128 + part * 8) = *(const LAS u32x4*)(lds + SC_OST + row * 272 + part * 16); }
        if (step + 1 < nch) scan_commit(R, lds, tid);
        __syncthreads();
    }
    if (!samp) { int ln2 = lane; asm volatile("" : "+v"(ln2));
        float* sp = state_out + ((size_t)((l * 2 + dir) * NB_P + b) * GH + h) * (DK * DV) + half * 128 + 16 * wave + (ln2 & 15) + (size_t)(4 * (ln2 >> 4)) * DV;
#pragma unroll
        for (int rt = 0; rt < 8; ++rt)
#pragma unroll
            for (int r = 0; r < 4; ++r) sp[(size_t)(16 * rt + r) * DV] = S[rt][r];
    }
}

__device__ __forceinline__ void pool_unit(int pu, const bf16_t* Z, bf16_t* POOLED, LAS unsigned char* lds, int tid) {
    const int ti = pu >> 6, g = (pu >> 4) & 3, cb = pu & 15, rowbase = ti * 2048, colbase = g * 256 + cb * 16, W = 2 << g;
    const bf16_t* src = Z + (size_t)rowbase * NZ + 3072 + colbase;
    LAS float* P = (LAS float*)lds;
#pragma unroll 4
    for (int it = 0; it < 8; ++it) { const int pc = tid + 512 * it, tok = pc >> 1, part = pc & 1;
        const u32x4 w = *(const u32x4*)(src + (size_t)tok * NZ + part * 8);
        LAS f32x4* d = (LAS f32x4*)(P + tok * 16 + part * 8);
        d[0] = (f32x4){bflo(w.x), bfhi(w.x), bflo(w.y), bfhi(w.y)}; d[1] = (f32x4){bflo(w.z), bfhi(w.z), bflo(w.w), bfhi(w.w)}; }
    __syncthreads();
    bf16_t* dst = POOLED + (size_t)rowbase * PW + colbase;
    if (ti >= 4) {
        { const int r = tid >> 4, ch = tid & 15; LAS float* p = P + (r * 64) * 16 + ch; float run = 0.f;
#pragma unroll 8
          for (int cc = 0; cc < 64; ++cc) { run += p[cc * 16]; p[cc * 16] = run; } }
        __syncthreads();
#pragma unroll 1
        for (int k = 0; k < 2; ++k) { const int item = tid + 512 * k, cc = item >> 4, ch = item & 15; LAS float* p = P + cc * 16 + ch; float run = 0.f;
#pragma unroll 8
          for (int r = 0; r < 32; ++r) { run += p[r * 1024]; p[r * 1024] = run; } }
        __syncthreads();
#pragma unroll 2
        for (int it = 0; it < 16; ++it) { const int item = tid + 512 * it, cq = item & 3, tok = item >> 2, r = tok >> 6, cc = tok & 63;
            const int lr = max(r - W / 2, 0), hr = min(r - W / 2 + W, 32), lc = max(cc - W / 2, 0), hc = min(cc - W / 2 + W, 64);
            const LAS float* p = P + cq * 4;
            f32x4 s = *(const LAS f32x4*)(p + ((hr - 1) * 64 + hc - 1) * 16);
            if (lr > 0) s -= *(const LAS f32x4*)(p + ((lr - 1) * 64 + hc - 1) * 16);
            if (lc > 0) s -= *(const LAS f32x4*)(p + ((hr - 1) * 64 + lc - 1) * 16);
            if (lr > 0 && lc > 0) s += *(const LAS f32x4*)(p + ((lr - 1) * 64 + lc - 1) * 16);
            const u32x2 ow = *(const u32x2*)(src + (size_t)tok * NZ + cq * 4);
            const f32x4 own = {bflo(ow.x), bfhi(ow.x), bflo(ow.y), bfhi(ow.y)};
            const f32x4 o = s * (1.0f / (float)((hr - lr) * (hc - lc))) - own;
            u32x2 w; w.x = pk2(o[0], o[1]); w.y = pk2(o[2], o[3]);
            *(u32x2*)(dst + (size_t)tok * PW + cq * 4) = w; }
    } else {
        if (tid < 128) { const int bb = tid >> 4, ch = tid & 15; LAS float* p = P + (bb * 256) * 16 + ch; float run = 0.f;
#pragma unroll 8
          for (int t = 0; t < 256; ++t) { run += p[t * 16]; p[t * 16] = run; } }
        __syncthreads();
#pragma unroll 2
        for (int it = 0; it < 16; ++it) { const int item = tid + 512 * it, cq = item & 3, tok = item >> 2, tt = tok & 255, base = tok - tt;
            const int lo = max(tt - W / 2, 0), hi = min(tt - W / 2 + W, 256);
            const LAS float* p = P + cq * 4;
            f32x4 s = *(const LAS f32x4*)(p + (base + hi - 1) * 16);
            if (lo > 0) s -= *(const LAS f32x4*)(p + (base + lo - 1) * 16);
            const u32x2 ow = *(const u32x2*)(src + (size_t)tok * NZ + cq * 4);
            const f32x4 own = {bflo(ow.x), bfhi(ow.x), bflo(ow.y), bfhi(ow.y)};
            const f32x4 o = s * (1.0f / (float)(hi - lo)) - own;
            u32x2 w; w.x = pk2(o[0], o[1]); w.y = pk2(o[2], o[3]);
            *(u32x2*)(dst + (size_t)tok * PW + cq * 4) = w; }
    }
    __syncthreads();
}
constexpr int NPOOLU = 12 * 4 * 16;

__device__ __forceinline__ void combine_phase(const bf16_t* OF, const bf16_t* OB, const bf16_t* Z, const float* gn, unsigned char* MIXED, int wave, int lane) {
    const int gw = blockIdx.x * 8 + wave, NGW = gridDim.x * 8;
    for (int row = gw; row < MT; row += NGW) {
#pragma unroll
        for (int j = 0; j < 2; ++j) { const int e = 8 * lane + 512 * j;
            const u32x4 a = *(const u32x4*)(OF + (size_t)row * GW + e), bq = *(const u32x4*)(OB + (size_t)row * GW + e), gg = *(const u32x4*)(Z + (size_t)row * NZ + 2048 + e);
            const f32x4 n0 = *(const f32x4*)(gn + e), n1 = *(const f32x4*)(gn + e + 4);
            float o[8], gt[8];
            o[0] = bflo(a.x) + bflo(bq.x); o[1] = bfhi(a.x) + bfhi(bq.x); o[2] = bflo(a.y) + bflo(bq.y); o[3] = bfhi(a.y) + bfhi(bq.y);
            o[4] = bflo(a.z) + bflo(bq.z); o[5] = bfhi(a.z) + bfhi(bq.z); o[6] = bflo(a.w) + bflo(bq.w); o[7] = bfhi(a.w) + bfhi(bq.w);
            gt[0] = bflo(gg.x); gt[1] = bfhi(gg.x); gt[2] = bflo(gg.y); gt[3] = bfhi(gg.y); gt[4] = bflo(gg.z); gt[5] = bfhi(gg.z); gt[6] = bflo(gg.w); gt[7] = bfhi(gg.w);
            float ss = 0.f;
#pragma unroll
            for (int k = 0; k < 8; ++k) ss += o[k] * o[k];
#pragma unroll
            for (int m = 1; m < 32; m <<= 1) ss += __shfl_xor(ss, m);
            const float r = 1.0f / sqrtf(ss * (1.0f / DV) + LN_EPS);
            float y[8];
#pragma unroll
            for (int k = 0; k < 8; ++k) y[k] = o[k] * r * (k < 4 ? n0[k] : n1[k - 4]) * silu_f(gt[k]);
            u32x2 w; w.x = pg8::pk_fp8x4(y[0] * SC_MIX8, y[1] * SC_MIX8, y[2] * SC_MIX8, y[3] * SC_MIX8); w.y = pg8::pk_fp8x4(y[4] * SC_MIX8, y[5] * SC_MIX8, y[6] * SC_MIX8, y[7] * SC_MIX8);
            *(u32x2*)(MIXED + (size_t)row * D + e) = w; }
    }
}

struct Args { const float* in[22]; float* out; unsigned char* ws; int ph_lo, ph_hi, nrep, pad; };
typedef __attribute__((address_space(4))) const Args* CArgsP;
__device__ __forceinline__ CArgsP get_args() { CArgsP p = (CArgsP)__builtin_amdgcn_kernarg_segment_ptr(); asm volatile("" : "+s"(p)); return p; }
#ifndef ONLY_PHASE
#define ONLY_PHASE -1
#endif
#define PHEN(k) (ONLY_PHASE < 0 || ONLY_PHASE == (k))
#ifndef PROBE_DUP
#define PROBE_DUP -1
#endif
#define REPS(k) for (int rep_ = 0; rep_ < ((PROBE_DUP == (k)) ? nrep : 1); ++rep_)
__global__ void __launch_bounds__(512, 2) mega_fwd(Args args) {
    extern __shared__ __attribute__((aligned(16))) unsigned char lds_raw[];
    LAS unsigned char* lds = (LAS unsigned char*)lds_raw;
    volatile LAS unsigned* MISC = (volatile LAS unsigned*)(lds + MISC_OFF);
    if (threadIdx.x < 16) MISC[threadIdx.x] = 0u;
    __syncthreads();
    const int ph_lo = args.ph_lo, ph_hi = args.ph_hi, nrep = args.nrep; (void)nrep;
    const bool one_launch = (ph_hi - ph_lo) > 1;
    XcdBarrier bar; bar.bar = (unsigned*)(args.ws + WS_CTL) + CW_BAR; bar.x = 0; bar.st = nullptr;
    if (one_launch) bar = xcd_barrier_post((unsigned*)(args.ws + WS_CTL) + CW_BAR, MISC + 8);
    int ph = 0;
#define RUN_PHASE() (ph >= ph_lo && ph < ph_hi)
#define SEAM() do { if (one_launch && ph >= ph_lo && ph + 1 < ph_hi) xcd_barrier(bar); ++ph; } while (0)
#define PHASE_LOCALS() int t_ = threadIdx.x; asm volatile("" : "+v"(t_)); const int tid = t_, lane = t_ & 63, wave = __builtin_amdgcn_readfirstlane(t_ >> 6); (void)lane; (void)wave; \
    CArgsP A = get_args(); unsigned char* ws = A->ws; const int G = gridDim.x; (void)G; (void)ws

    if (PHEN(0) && RUN_PHASE()) REPS(0) { PHASE_LOCALS();
        compute_mods(A->in[3], A->in[4], A->in[7], A->in[8], (float*)(ws + WS_MODS), lds, tid, wave, lane);
        __syncthreads();
        convert_weights(A->in[9], A->in[15], A->in[18], A->in[19], A->in[13], ws, lds, wave, lane);
    }
    SEAM();
    if (PHEN(1) && RUN_PHASE()) REPS(1) { PHASE_LOCALS();
        ln_phase<0, 2>(A->in[0], A->in[1], (bf16_t*)(ws + WS_X), nullptr, (bf16_t*)(ws + WS_H), (unsigned char*)(ws + WS_POOLED), nullptr, A->in[5], A->in[6], nullptr, 0, (const float*)(ws + WS_MODS), 0, D, true, lds, tid, wave, lane); }
    SEAM();

#pragma unroll 1
    for (int l = 0; l < DEPTH; ++l) {
        if (PHEN(2) && RUN_PHASE()) REPS(2) { PHASE_LOCALS();
            const bf16_t* H = (const bf16_t*)(ws + WS_H);
            { pg8::Gemm g{H, (const bf16_t*)(ws + WS_WIN) + (size_t)l * NZ * D, MP, 2048, D, D, D, 0}; pg8::StaticOrder S; S.init(MP, 2048, G, (int)blockIdx.x);
              pg8::EpiBf16<false> E{(bf16_t*)(ws + WS_Z), NZ, nullptr, 1.0f};
              pg8::gemm_phase<pg8::EpiBf16<false>, pg8::StaticOrder, PG8_ALIGN, PG8_SP2>(lds, g, S, E, tid); }
            gates_gemm(H, (const bf16_t*)(ws + WS_WG) + (size_t)l * 32 * D, (float*)(ws + WS_GATES), wave, lane);
        }
        if (PHEN(12) && RUN_PHASE()) REPS(12) { PHASE_LOCALS();
            { pg8::Gemm g{(const bf16_t*)(ws + WS_POOLED) + (size_t)MP * (D / 2), (const bf16_t*)(ws + WS_WIN8) + (size_t)l * NZ * (D / 2), MS, NZ, D / 2, D / 2, D / 2, 0}; pg8::StaticOrder S; S.init(MS, NZ, G, (int)blockIdx.x);
              pg8::EpiBf16<false> E{(bf16_t*)(ws + WS_Z) + (size_t)MP * NZ, NZ, nullptr, 1.0f / (SC_H8 * SC_WIN8)};
              pg8::gemm_phase<pg8::EpiBf16<false>, pg8::StaticOrder, PG8_ALIGN, PG8_SP2, true>(lds, g, S, E, tid); }
        }
        if (PHEN(13) && RUN_PHASE()) REPS(13) { PHASE_LOCALS();
            { pg8::Gemm g{(const bf16_t*)(ws + WS_POOLED), (const bf16_t*)(ws + WS_WIN8) + ((size_t)l * NZ + 2048) * (D / 2), MP, 2048, D / 2, D / 2, D / 2, 0}; pg8::StaticOrder S; S.init(MP, 2048, G, (int)blockIdx.x);
              pg8::EpiBf16<false> E{(bf16_t*)(ws + WS_Z) + 2048, NZ, nullptr, 1.0f / (SC_H8 * SC_WIN8)};
              pg8::gemm_phase<pg8::EpiBf16<false>, pg8::StaticOrder, PG8_ALIGN, PG8_SP2, true>(lds, g, S, E, tid); }
        }
        SEAM();
        if (PHEN(3) && RUN_PHASE()) REPS(3) { PHASE_LOCALS();
            const bf16_t* Z = (const bf16_t*)(ws + WS_Z);
            for (int u = blockIdx.x; u < NPREP / 2; u += G) gla_prep_unit(u, l, Z, (const float*)(ws + WS_GATES), A->in[10], A->in[11], (bf16_t*)(ws + WS_QE), (bf16_t*)(ws + WS_KDT), (bf16_t*)(ws + WS_AM), (float*)(ws + WS_DEC), lds, tid, wave, lane);
            for (int pu = blockIdx.x; pu < NPOOLU; pu += G) pool_unit(pu, Z, (bf16_t*)(ws + WS_POOLED), lds, tid);
        }
        SEAM();
        if (PHEN(4) && RUN_PHASE()) REPS(4) { PHASE_LOCALS();
            const int bx = blockIdx.x;
            const bf16_t* Z = (const bf16_t*)(ws + WS_Z); const bf16_t* QE = (const bf16_t*)(ws + WS_QE); const bf16_t* KDT = (const bf16_t*)(ws + WS_KDT); const bf16_t* AM = (const bf16_t*)(ws + WS_AM);
            const float* DEC = (const float*)(ws + WS_DEC); const float* state_gla = A->in[2]; float* out_state = A->out + (size_t)MT * D; bf16_t* OF = (bf16_t*)(ws + WS_OF); bf16_t* OB = (bf16_t*)(ws + WS_OB);
            if (G >= 256) { const int stride = bx < 128 ? 4096 : G - 128; for (int ch = bx; ch < 640; ch += stride) gla_scan_chain(ch, l, Z, QE, KDT, AM, DEC, state_gla, out_state, OF, OB, lds, tid, wave, lane); }
            else { for (int ch = bx; ch < 640; ch += G) gla_scan_chain(ch, l, Z, QE, KDT, AM, DEC, state_gla, out_state, OF, OB, lds, tid, wave, lane); }
        }
        if (PHEN(11) && RUN_PHASE()) REPS(11) { PHASE_LOCALS();
            const int bx = blockIdx.x;
            pg8::Gemm g{(const bf16_t*)(ws + WS_POOLED), (const bf16_t*)(ws + WS_WPOOL) + (size_t)l * 4 * 65536, MT, 1024, 256, PW, 256, 512};
            pg8::StaticOrder S; if (G >= 256) S.init(MT, 1024, G - 128, bx - 128); else S.init(MT, 1024, G, bx);
            pg8::EpiFp8Col E{(unsigned char*)(ws + WS_MIXED) + GW, D, A->in[14] + (size_t)l * PW, SC_MIX8};
            pg8::gemm_phase<pg8::EpiFp8Col, pg8::StaticOrder, PG8_ALIGN, PG8_SP2>(lds, g, S, E, tid);
        }
        SEAM();
        if (PHEN(5) && RUN_PHASE()) REPS(5) { PHASE_LOCALS();
            combine_phase((const bf16_t*)(ws + WS_OF), (const bf16_t*)(ws + WS_OB), (const bf16_t*)(ws + WS_Z), A->in[12] + (size_t)l * GW, (unsigned char*)(ws + WS_MIXED), wave, lane); }
        SEAM();
        if (PHEN(6) && RUN_PHASE()) REPS(6) { PHASE_LOCALS();
            pg8::Gemm g{(const bf16_t*)(ws + WS_MIXED), (const bf16_t*)(ws + WS_WOUT) + (size_t)l * D * (D / 2), MT, D, D / 2, D / 2, D / 2, 0}; pg8::StaticOrder S; S.init(MT, D, G, (int)blockIdx.x);
            pg8::EpiBf16<false> E{(bf16_t*)(ws + WS_MB), D, nullptr, 1.0f / (SC_MIX8 * SC_WOUT8)};
            pg8::gemm_phase<pg8::EpiBf16<false>, pg8::StaticOrder, PG8_ALIGN, PG8_SP2, true>(lds, g, S, E, tid);
        }
        SEAM();
        if (PHEN(7) && RUN_PHASE()) REPS(7) { PHASE_LOCALS();
            const float* modl = (const float*)(ws + WS_MODS) + (size_t)l * NMOD * MODW;
            ln_phase<1, 1>(nullptr, nullptr, (bf16_t*)(ws + WS_X), (const bf16_t*)(ws + WS_MB), nullptr, (unsigned char*)(ws + WS_H), nullptr, A->in[16] + (size_t)l * D, A->in[17] + (size_t)l * D, modl, 2 * D, modl, 3 * D, 4 * D, true, lds, tid, wave, lane); }
        SEAM();
        if (PHEN(8) && RUN_PHASE()) REPS(8) { PHASE_LOCALS();
            pg8::Gemm g{(const bf16_t*)(ws + WS_H), (const bf16_t*)(ws + WS_WGU) + (size_t)l * NGU * (D / 2), MT, NGU, D / 2, D / 2, D / 2, 0}; pg8::StaticOrder S; S.init(MT, NGU, G, (int)blockIdx.x);
            pg8::EpiSwiGLU8 E{(unsigned char*)(ws + WS_ACT), DFF, 1.0f / (SC_H8 * SC_WGU8), SC_ACT8};
            pg8::gemm_phase<pg8::EpiSwiGLU8, pg8::StaticOrder, PG8_ALIGN, PG8_SP2, true>(lds, g, S, E, tid);
        }
        SEAM();
        if (PHEN(9) && RUN_PHASE()) REPS(9) { PHASE_LOCALS();
            pg8::Gemm g{(const bf16_t*)(ws + WS_ACT), (const bf16_t*)(ws + WS_WDN) + (size_t)l * D * (DFF / 2), MT, D, DFF / 2, DFF / 2, DFF / 2, 0}; pg8::StaticOrder S; S.init(MT, D, G, (int)blockIdx.x);
            pg8::EpiBf16<false> E{(bf16_t*)(ws + WS_MB), D, nullptr, 1.0f / (SC_ACT8 * SC_WDN8)};
            pg8::gemm_phase<pg8::EpiBf16<false>, pg8::StaticOrder, PG8_ALIGN, PG8_SP2, true>(lds, g, S, E, tid);
        }
        SEAM();
        if (PHEN(10) && RUN_PHASE()) REPS(10) { PHASE_LOCALS();
            const bool lastl = (l == DEPTH - 1);
            const float* modl = (const float*)(ws + WS_MODS) + (size_t)l * NMOD * MODW;
            ln_phase<1, 2>(nullptr, nullptr, (bf16_t*)(ws + WS_X), (const bf16_t*)(ws + WS_MB), (bf16_t*)(ws + WS_H), (unsigned char*)(ws + WS_POOLED), lastl ? A->out : nullptr, A->in[20] + (size_t)l * D, A->in[21] + (size_t)l * D, modl, 5 * D, modl + (size_t)NMOD * MODW, 0, D, !lastl, lds, tid, wave, lane);
        }
        SEAM();
    }
#undef RUN_PHASE
#undef SEAM
}
constexpr int N_PHASES = 2 + 9 * DEPTH;

#ifndef MK_SPLIT
#define MK_SPLIT 0
#endif
extern "C" void kernel_launch(void* const* d_in, const int* in_sizes, int n_in, void* d_out, int out_size, void* d_ws, size_t ws_size, hipStream_t stream) {
    static int grid = 0;
    if (grid == 0) {
        if (n_in != 22 || ws_size < WS_END) { fprintf(stderr, "kernel_launch: expected 22 inputs and >= %zu bytes of workspace; got %d, %zu\n", (size_t)WS_END, n_in, ws_size); grid = -1; return; }
        int dev = 0, cus = 0;
        if (hipGetDevice(&dev) != hipSuccess || hipDeviceGetAttribute(&cus, hipDeviceAttributeMultiprocessorCount, dev) != hipSuccess) { fprintf(stderr, "kernel_launch: device query failed\n"); grid = -1; return; }
        if (hipFuncSetAttribute((const void*)mega_fwd, hipFuncAttributeMaxDynamicSharedMemorySize, LDS_BYTES) != hipSuccess) { fprintf(stderr, "kernel_launch: hipFuncSetAttribute failed\n"); grid = -1; return; }
        int per_cu = 0;
        if (hipOccupancyMaxActiveBlocksPerMultiprocessor(&per_cu, (const void*)mega_fwd, 512, LDS_BYTES) != hipSuccess || per_cu < 1) fprintf(stderr, "kernel_launch: occupancy query says %d\n", per_cu);
        (void)hipGetLastError();
        grid = cus;
    }
    if (grid < 0) return;
    (void)in_sizes; (void)out_size;
    (void)hipMemsetAsync((char*)d_ws + WS_CTL, 0, CTL_ZERO_BYTES, stream);
    Args a{};
    for (int i = 0; i < 22; ++i) a.in[i] = (const float*)d_in[i];
    a.out = (float*)d_out; a.ws = (unsigned char*)d_ws; a.nrep = 2; a.pad = 0;
#if MK_SPLIT
    for (int p = 0; p < N_PHASES; ++p) { a.ph_lo = p; a.ph_hi = p + 1; hipLaunchKernelGGL(mega_fwd, dim3(grid), dim3(512), LDS_BYTES, stream, a); }
#else
    a.ph_lo = 0; a.ph_hi = N_PHASES;
    hipLaunchKernelGGL(mega_fwd, dim3(grid), dim3(512), LDS_BYTES, stream, a);
#endif
    const hipError_t le = hipPeekAtLastError();
    if (le != hipSuccess) fprintf(stderr, "kernel_launch: launch failed: %s\n", hipGetErrorName(le));
}
```

```cpp
#include <hip/hip_runtime.h>
#include <cstdio>
#include <cstdint>

#define LAS __attribute__((address_space(3)))
typedef unsigned short bf16_t;
typedef short bf16x8 __attribute__((ext_vector_type(8)));
typedef short s16x4 __attribute__((ext_vector_type(4)));
typedef float f32x4 __attribute__((ext_vector_type(4)));
typedef float f32x2 __attribute__((ext_vector_type(2)));
typedef unsigned u32x4 __attribute__((ext_vector_type(4)));
typedef unsigned u32x2 __attribute__((ext_vector_type(2)));

constexpr int D = 2048, DEPTH = 4;
constexpr int NB_P = 32, L_P = 256, NB_S = 8, L_S = 2048;
constexpr int MP = NB_P * L_P, MS = NB_S * L_S, MT = MP + MS;
constexpr int GH = 4, DK = 128, DV = 256, KW = 512, GW = 1024, PW = 1024, RANK = 16;
constexpr int INW = 4128, NZ = 4096, DFF = 5632, NGU = 2 * DFF;
constexpr int NMOD = 9, MODW = 6 * D;
constexpr float LN_EPS = 1e-5f;
constexpr float ALPHA = 1.681792830507429f;
constexpr float QSCALE = 0.08838834764831845f;
constexpr int NCHUNK = MT / 64;
constexpr int NPREP = NCHUNK * GH * 2;

constexpr size_t MiB = 1u << 20;
constexpr size_t WS_CTL = 0, CTL_ZERO_BYTES = 128 * 1024;
constexpr size_t WS_MODS = 1 * MiB;
constexpr size_t WS_WG = 3 * MiB;
constexpr size_t WS_WPOOL = 4 * MiB;
constexpr size_t WS_WIN = 6 * MiB;
constexpr size_t WS_WOUT = 70 * MiB;
constexpr size_t WS_WIN8 = 190 * MiB;
constexpr size_t WS_WGU = 102 * MiB;
constexpr size_t WS_WDN = 278 * MiB;
constexpr size_t WS_X = 366 * MiB;
constexpr size_t WS_H = 558 * MiB;
constexpr size_t WS_MB = 654 * MiB;
constexpr size_t WS_POOLED = 846 * MiB;
constexpr size_t WS_GATES = 894 * MiB;
constexpr size_t WS_Z = 898 * MiB;
constexpr size_t WS_OF = 1090 * MiB;
constexpr size_t WS_OB = 1138 * MiB;
constexpr size_t WS_MIXED = 1186 * MiB;
constexpr size_t WS_QE = 1282 * MiB;
constexpr size_t WS_KDT = 1330 * MiB;
constexpr size_t WS_AM = 1378 * MiB;
constexpr size_t WS_DEC = 1402 * MiB;
constexpr size_t WS_END = 1404 * MiB;
constexpr size_t WS_ACT = 898 * MiB;
static_assert(WS_ACT + (size_t)MT * DFF * 2 <= WS_MIXED, "ACT overlay");
constexpr int CW_BAR = 4096;

constexpr int RING_BYTES = 131072;
constexpr int MISC_OFF = RING_BYTES;
constexpr int LDS_BYTES = 147456;

__device__ __forceinline__ unsigned f2bf(float f) { unsigned u = __builtin_bit_cast(unsigned, f); return (u + 0x7fffu + ((u >> 16) & 1u)) >> 16; }
__device__ __forceinline__ unsigned pk2(float lo, float hi) { return f2bf(lo) | (f2bf(hi) << 16); }
__device__ __forceinline__ float bf2f(unsigned short b) { return __builtin_bit_cast(float, ((unsigned)b) << 16); }
__device__ __forceinline__ float bflo(unsigned w) { return __builtin_bit_cast(float, w << 16); }
__device__ __forceinline__ float bfhi(unsigned w) { return __builtin_bit_cast(float, w & 0xffff0000u); }
__device__ __forceinline__ float wave_sum(float v) {
#pragma unroll
    for (int o = 1; o < 64; o <<= 1) v += __shfl_xor(v, o);
    return v;
}
typedef _Float16 f16x2 __attribute__((ext_vector_type(2)));
__device__ __forceinline__ unsigned pkh2(float lo, float hi) { const f16x2 v = {(_Float16)lo, (_Float16)hi}; return __builtin_bit_cast(unsigned, v); }
__device__ __forceinline__ float h2lo(unsigned w) { return (float)__builtin_bit_cast(f16x2, w)[0]; }
__device__ __forceinline__ float h2hi(unsigned w) { return (float)__builtin_bit_cast(f16x2, w)[1]; }
__device__ __forceinline__ float silu_f(float x) { return x / (1.0f + __expf(-x)); }

namespace pg8 {
#define PG8_LAS __attribute__((address_space(3)))
constexpr int BM = 256, BK = 64, HALF = 128, HTB = HALF * BK * 2  , STAGE_BYTES = 8 * HTB, NXCD = 8, WGM = 8;

__host__ __device__ __forceinline__ int lds_byte(int r, int c) { const int st = (r >> 4) * 2 + (c >> 5), rr = r & 15, cc = c & 31, ob = rr * 64 + cc * 2; return st * 1024 + (ob ^ (((ob >> 9) & 1) << 5)); }
__host__ __device__ __forceinline__ void stage_rc(int b, int& R, int& C) { const int st = b / 1024, sb = b % 1024, swz = sb ^ (((sb >> 9) & 1) << 5); R = (st >> 1) * 16 + swz / 64; C = (st & 1) * 32 + (swz % 64) / 2; }
__host__ __device__ __forceinline__ int perm32(int rho) { const int n = rho >> 4, i = rho & 15; return 8 * (i >> 2) + 4 * n + (i & 3); }

struct Unit { int pm, pn; };
struct Gemm { const bf16_t* A; const bf16_t* Bt; int M, N, K, lda, ldb, a_pn_off; };

struct StaticOrder {
    int nM, nN, nwg, G, c;
    __host__ __device__ void init(int M, int N, int G_, int c_) { nM = M / BM; nN = N / BM; nwg = nM * nN; G = G_; c = c_; }
    __host__ __device__ bool next(int i, Unit& u) const {
        const long L = (long)i * G + c; if (c < 0 || L >= nwg) return false;
        int wgid = (int)L; { const int q = nwg / NXCD, r = nwg % NXCD, xcd = wgid % NXCD, off = wgid / NXCD; wgid = (xcd < r ? xcd * (q + 1) : r * (q + 1) + (xcd - r) * q) + off; }
        const int nig = WGM * nN, gid = wgid / nig, fm = gid * WGM, gsz = (nM - fm) < WGM ? (nM - fm) : WGM;
        u.pm = fm + ((wgid % nig) % gsz); u.pn = (wgid % nig) / gsz; return true;
    }
    __device__ __forceinline__ void a_ready(const Unit&) const {}
    __device__ __forceinline__ void done(const Unit&) const {}
};

__device__ __forceinline__ unsigned cvt_pk_bf16(float lo, float hi) { unsigned r; asm volatile("v_cvt_pk_bf16_f32 %0, %1, %2" : "=v"(r) : "v"(lo), "v"(hi)); return r; }

struct EpiF32 {
    static constexpr bool PERM = false, AFTER_DRAIN = false;
    float* C; int ldc; float sc;
    __device__ __forceinline__ void operator()(const f32x4 (&acc)[2][2][4][2], const Unit& u, int wr, int wc, int fr, int fq) const {
        const int row0 = u.pm * BM + wr * 64 + fr, col0 = u.pn * BM + wc * 32 + 4 * fq;
#pragma unroll
        for (int ai = 0; ai < 2; ++ai)
#pragma unroll
            for (int m = 0; m < 4; ++m) { float* rowp = C + (size_t)(row0 + ai * HALF + m * 16) * ldc + col0;
#pragma unroll
                for (int bj = 0; bj < 2; ++bj)
#pragma unroll
                    for (int n = 0; n < 2; ++n) *(f32x4*)(rowp + bj * HALF + n * 16) = acc[ai][bj][m][n] * sc; }
    }
};
__device__ __forceinline__ unsigned pk_fp8x4(float a, float b, float c, float d) {
    int w = 0;
    w = __builtin_amdgcn_cvt_pk_fp8_f32(__builtin_amdgcn_fmed3f(a, -448.f, 448.f), __builtin_amdgcn_fmed3f(b, -448.f, 448.f), w, false);
    w = __builtin_amdgcn_cvt_pk_fp8_f32(__builtin_amdgcn_fmed3f(c, -448.f, 448.f), __builtin_amdgcn_fmed3f(d, -448.f, 448.f), w, true);
    return (unsigned)w;
}
struct EpiFp8Col {
    static constexpr bool PERM = true, AFTER_DRAIN = false;
    unsigned char* O; int ldc; const float* scale; float usc;
    __device__ __forceinline__ void operator()(const f32x4 (&acc)[2][2][4][2], const Unit& u, int wr, int wc, int fr, int fq) const {
        const int row0 = u.pm * BM + wr * 64 + fr; const int col0 = u.pn * BM + wc * 32 + 8 * fq;
#pragma unroll
        for (int bj = 0; bj < 2; ++bj) {
            const f32x4 s0 = *(const f32x4*)(scale + col0 + bj * HALF) * usc, s1 = *(const f32x4*)(scale + col0 + bj * HALF + 4) * usc;
#pragma unroll
            for (int ai = 0; ai < 2; ++ai)
#pragma unroll
                for (int m = 0; m < 4; ++m) { unsigned char* rowp = O + (size_t)(row0 + ai * HALF + m * 16) * ldc + col0 + bj * HALF;
                    const f32x4 v0 = acc[ai][bj][m][0] * s0, v1 = acc[ai][bj][m][1] * s1;
                    u32x2 w; w.x = pk_fp8x4(v0[0], v0[1], v0[2], v0[3]); w.y = pk_fp8x4(v1[0], v1[1], v1[2], v1[3]);
                    *(u32x2*)rowp = w; } }
    }
};
template <bool SCALED> struct EpiBf16 {
    static constexpr bool PERM = true, AFTER_DRAIN = false;
    bf16_t* O; int ldc; const float* scale; float usc;
    __device__ __forceinline__ void operator()(const f32x4 (&acc)[2][2][4][2], const Unit& u, int wr, int wc, int fr, int fq) const {
        const int row0 = u.pm * BM + wr * 64 + fr; const int col0 = u.pn * BM + wc * 32 + 8 * fq;
#pragma unroll
        for (int bj = 0; bj < 2; ++bj) {
            f32x4 s0 = {usc, usc, usc, usc}, s1 = {usc, usc, usc, usc};
            if (SCALED) { s0 = *(const f32x4*)(scale + col0 + bj * HALF); s1 = *(const f32x4*)(scale + col0 + bj * HALF + 4); }
#pragma unroll
            for (int ai = 0; ai < 2; ++ai)
#pragma unroll
                for (int m = 0; m < 4; ++m) { bf16_t* rowp = O + (size_t)(row0 + ai * HALF + m * 16) * ldc + col0 + bj * HALF;
                    f32x4 v0 = acc[ai][bj][m][0], v1 = acc[ai][bj][m][1];
                    v0 = v0 * s0; v1 = v1 * s1;
                    u32x4 w; w.x = cvt_pk_bf16(v0[0], v0[1]); w.y = cvt_pk_bf16(v0[2], v0[3]); w.z = cvt_pk_bf16(v1[0], v1[1]); w.w = cvt_pk_bf16(v1[2], v1[3]);
                    *(u32x4*)rowp = w; } }
    }
};
struct EpiSwiGLU8 {
    static constexpr bool PERM = true, AFTER_DRAIN = false;
    unsigned char* O; int ldc; float insc, outsc;
    __device__ __forceinline__ void operator()(const f32x4 (&acc)[2][2][4][2], const Unit& u, int wr, int wc, int fr, int fq) const {
        const int row0 = u.pm * BM + wr * 64 + fr; const int col0 = u.pn * HALF + wc * 32 + 8 * fq;
        const float c1 = -insc * 1.4426950408889634f, c2 = insc * insc * outsc;
#pragma unroll
        for (int ai = 0; ai < 2; ++ai)
#pragma unroll
            for (int m = 0; m < 4; ++m) { unsigned char* rowp = O + (size_t)(row0 + ai * HALF + m * 16) * ldc + col0;
                float r[8];
#pragma unroll
                for (int n = 0; n < 2; ++n)
#pragma unroll
                    for (int j = 0; j < 4; ++j) { const float a0 = acc[ai][0][m][n][j], a1 = acc[ai][1][m][n][j];
                        r[n * 4 + j] = (a0 * a1) * c2 * __builtin_amdgcn_rcpf(1.0f + __builtin_amdgcn_exp2f(a0 * c1)); }
                u32x2 w; w.x = pk_fp8x4(r[0], r[1], r[2], r[3]); w.y = pk_fp8x4(r[4], r[5], r[6], r[7]);
                *(u32x2*)rowp = w; }
    }
};
typedef int i32x4 __attribute__((ext_vector_type(4)));
typedef int i32x8 __attribute__((ext_vector_type(8)));
template <class Epi, class Sched, bool ALIGN_EPI = false, bool SP2 = false, bool FP8 = false>
__device__ __forceinline__ void gemm_phase(PG8_LAS unsigned char* lds, const Gemm g, const Sched& S, const Epi& E, const int tid) {
    const int wid = __builtin_amdgcn_readfirstlane(tid >> 6), lane = tid & 63, wr = wid >> 2, wc = wid & 3, fr = lane & 15, fq = lane >> 4;
    const int K = g.K, nt = K / BK;
    unsigned voffA[2], voffB[2];
#pragma unroll
    for (int i = 0; i < 2; ++i) { int R, C; stage_rc(tid * 16 + i * 8192, R, C); const int Rb = Epi::PERM ? ((R & ~31) + perm32(R & 31)) : R;
        voffA[i] = (unsigned)(R * g.lda + C) * 2u; voffB[i] = (unsigned)(Rb * g.ldb + C) * 2u; }
    const size_t kstep = (size_t)(BK * 2);
    const size_t hstepA = (size_t)HALF * g.lda * 2, hstepB = (size_t)HALF * g.ldb * 2;
    const size_t tstepA = 2 * hstepA, tstepB = 2 * hstepB;
    const unsigned ldsw = (unsigned)wid * 1024u;
    const int aoff = lds_byte(wr * 64 + fr, fq * 8), boff = lds_byte(wc * 32 + fr, fq * 8);
#define PG8_SA(b, h) (((b) * 2 + (h)) * HTB)
#define PG8_SB(b, h) ((4 + (b) * 2 + (h)) * HTB)
#define PG8_STAGE(bufoff, gbase, voff) do { _Pragma("unroll") for (int _i = 0; _i < 2; ++_i) \
        __builtin_amdgcn_global_load_lds((const unsigned*)((const char*)(gbase) + (voff)[_i]), (PG8_LAS unsigned*)(lds + (bufoff) + ldsw + _i * 8192), 16, 0, 0); } while (0)
#define PG8_LDA(dst, b, h) do { if constexpr (FP8) { _Pragma("unroll") for (int m = 0; m < 4; ++m) dst##8[m] = __builtin_shufflevector(*(const PG8_LAS i32x4*)(lds + PG8_SA(b, h) + aoff + m * 2048), *(const PG8_LAS i32x4*)(lds + PG8_SA(b, h) + aoff + m * 2048 + 1024), 0, 1, 2, 3, 4, 5, 6, 7); } \
        else { _Pragma("unroll") for (int m = 0; m < 4; ++m) _Pragma("unroll") for (int k = 0; k < 2; ++k) dst[m][k] = *(const PG8_LAS bf16x8*)(lds + PG8_SA(b, h) + aoff + m * 2048 + k * 1024); } } while (0)
#define PG8_LDB(dst, b, h) do { if constexpr (FP8) { _Pragma("unroll") for (int n = 0; n < 2; ++n) dst##8[n] = __builtin_shufflevector(*(const PG8_LAS i32x4*)(lds + PG8_SB(b, h) + boff + n * 2048), *(const PG8_LAS i32x4*)(lds + PG8_SB(b, h) + boff + n * 2048 + 1024), 0, 1, 2, 3, 4, 5, 6, 7); } \
        else { _Pragma("unroll") for (int n = 0; n < 2; ++n) _Pragma("unroll") for (int k = 0; k < 2; ++k) dst[n][k] = *(const PG8_LAS bf16x8*)(lds + PG8_SB(b, h) + boff + n * 2048 + k * 1024); } } while (0)
#define PG8_MMA(ai, bj, At, Bt) do { __builtin_amdgcn_s_setprio(1); \
        if constexpr (FP8) { _Pragma("unroll") for (int m = 0; m < 4; ++m) _Pragma("unroll") for (int n = 0; n < 2; ++n) \
            asm volatile("v_mfma_f32_16x16x128_f8f6f4 %0, %1, %2, %0" : "+v"(acc[ai][bj][m][n]) : "v"(Bt##8[n]), "v"(At##8[m])); } \
        else { _Pragma("unroll") for (int m = 0; m < 4; ++m) _Pragma("unroll") for (int n = 0; n < 2; ++n) _Pragma("unroll") for (int k = 0; k < 2; ++k) \
            acc[ai][bj][m][n] = __builtin_amdgcn_mfma_f32_16x16x32_bf16(Bt[n][k], At[m][k], acc[ai][bj][m][n], 0, 0, 0); } \
        __builtin_amdgcn_s_setprio(0); } while (0)
#define PG8_WAIT_V(n) asm volatile("s_waitcnt vmcnt(" #n ")" ::: "memory")
#define PG8_WAIT_L(n) asm volatile("s_waitcnt lgkmcnt(" #n ")" ::: "memory")
#define PG8_BAR __builtin_amdgcn_s_barrier()
#define PG8_SCHED __builtin_amdgcn_sched_barrier(0)
    Unit cur, nxt; int ui = 0;
    if (!S.next(0, cur)) return;
    f32x4 acc[2][2][4][2];
#pragma unroll
    for (int a = 0; a < 2; ++a)
#pragma unroll
        for (int b = 0; b < 2; ++b)
#pragma unroll
            for (int m = 0; m < 4; ++m)
#pragma unroll
                for (int n = 0; n < 2; ++n) acc[a][b][m][n] = (f32x4){0.f, 0.f, 0.f, 0.f};
    bf16x8 At[4][2], B0[2][2], B1[2][2]; i32x8 At8[4], B08[2], B18[2]; (void)At; (void)B0; (void)B1; (void)At8; (void)B08; (void)B18;
    const char* cA = (const char*)g.A + (size_t)cur.pm * tstepA + (size_t)cur.pn * g.a_pn_off; const char* cB = (const char*)g.Bt + (size_t)cur.pn * tstepB;
    S.a_ready(cur);
    if constexpr (SP2) {
        PG8_STAGE(PG8_SB(0, 0), cB, voffB); PG8_STAGE(PG8_SB(0, 1), cB + hstepB, voffB); PG8_STAGE(PG8_SA(0, 0), cA, voffA); PG8_STAGE(PG8_SA(0, 1), cA + hstepA, voffA);
        if (wr == 1) PG8_BAR;
        PG8_WAIT_V(2); PG8_BAR;
        PG8_STAGE(PG8_SB(1, 0), cB + kstep, voffB); PG8_STAGE(PG8_SA(1, 0), cA + kstep, voffA); PG8_STAGE(PG8_SB(1, 1), cB + hstepB + kstep, voffB);
        PG8_WAIT_V(6); PG8_BAR;
    } else {
        PG8_STAGE(PG8_SB(0, 0), cB, voffB); PG8_STAGE(PG8_SA(0, 0), cA, voffA); PG8_STAGE(PG8_SB(0, 1), cB + hstepB, voffB); PG8_STAGE(PG8_SA(0, 1), cA + hstepA, voffA);
        if (wr == 1) PG8_BAR;
        PG8_WAIT_V(4); PG8_BAR;
        PG8_STAGE(PG8_SB(1, 0), cB + kstep, voffB); PG8_STAGE(PG8_SA(1, 0), cA + kstep, voffA); PG8_STAGE(PG8_SB(1, 1), cB + hstepB + kstep, voffB);
        PG8_WAIT_V(6); PG8_BAR;
    }
    for (;;) {
        const bool has_next = S.next(ui + 1, nxt);
        const char* nA = has_next ? (const char*)g.A + (size_t)nxt.pm * tstepA + (size_t)nxt.pn * g.a_pn_off : cA; const char* nB = has_next ? (const char*)g.Bt + (size_t)nxt.pn * tstepB : cB;
#pragma unroll 1
        for (int t = 0; t < nt; t += 2) {
            const bool last = (t == nt - 2);
            const char* a1 = cA + (size_t)(t + 1) * kstep;
            const char* a2 = last ? nA : cA + (size_t)(t + 2) * kstep; const char* b2 = last ? nB : cB + (size_t)(t + 2) * kstep;
            const char* a3 = a2 + kstep; const char* b3 = b2 + kstep;
            if (last && has_next) S.a_ready(nxt);
            if constexpr (SP2) {
            PG8_LDB(B0, 0, 0); PG8_LDB(B1, 0, 1); PG8_SCHED; PG8_LDA(At, 0, 0); PG8_STAGE(PG8_SA(1, 1), a1 + hstepA, voffA);
            PG8_WAIT_V(8); PG8_WAIT_L(0); PG8_BAR; PG8_MMA(0, 0, At, B0); PG8_MMA(0, 1, At, B1); PG8_BAR; PG8_SCHED;
            PG8_LDA(At, 0, 1); PG8_STAGE(PG8_SB(0, 0), b2, voffB); PG8_STAGE(PG8_SB(0, 1), b2 + hstepB, voffB); PG8_STAGE(PG8_SA(0, 0), a2, voffA);
            PG8_WAIT_V(8); PG8_WAIT_L(0); PG8_BAR; PG8_MMA(1, 0, At, B0); PG8_MMA(1, 1, At, B1); PG8_BAR; PG8_SCHED;
            PG8_LDB(B0, 1, 0); PG8_LDB(B1, 1, 1); PG8_SCHED; PG8_LDA(At, 1, 0); PG8_STAGE(PG8_SA(0, 1), a2 + hstepA, voffA);
            PG8_WAIT_V(8); PG8_WAIT_L(0); PG8_BAR; PG8_MMA(0, 0, At, B0); PG8_MMA(0, 1, At, B1); PG8_BAR; PG8_SCHED;
            PG8_LDA(At, 1, 1); PG8_STAGE(PG8_SB(1, 0), b3, voffB); PG8_STAGE(PG8_SB(1, 1), b3 + hstepB, voffB); PG8_STAGE(PG8_SA(1, 0), a3, voffA);
            PG8_WAIT_V(8); PG8_WAIT_L(0); PG8_BAR; PG8_MMA(1, 0, At, B0); PG8_MMA(1, 1, At, B1); PG8_BAR; PG8_SCHED;
            } else {
            PG8_LDB(B0, 0, 0); PG8_SCHED; PG8_LDA(At, 0, 0); PG8_STAGE(PG8_SA(1, 1), a1 + hstepA, voffA);
            PG8_WAIT_L(8); PG8_BAR; PG8_WAIT_L(0); PG8_MMA(0, 0, At, B0); PG8_BAR; PG8_SCHED;
            PG8_LDB(B1, 0, 1); PG8_STAGE(PG8_SB(0, 0), b2, voffB);
            PG8_BAR; PG8_WAIT_L(0); PG8_MMA(0, 1, At, B1); PG8_BAR;
            PG8_LDA(At, 0, 1); PG8_STAGE(PG8_SA(0, 0), a2, voffA);
            PG8_BAR; PG8_WAIT_L(0); PG8_MMA(1, 0, At, B0); PG8_BAR; PG8_SCHED;
            PG8_STAGE(PG8_SB(0, 1), b2 + hstepB, voffB);
            PG8_WAIT_V(6); PG8_BAR; PG8_MMA(1, 1, At, B1); PG8_BAR;
            PG8_LDB(B0, 1, 0); PG8_SCHED; PG8_LDA(At, 1, 0); PG8_STAGE(PG8_SA(0, 1), a2 + hstepA, voffA);
            PG8_WAIT_L(8); PG8_BAR; PG8_WAIT_L(0); PG8_MMA(0, 0, At, B0); PG8_BAR; PG8_SCHED;
            PG8_LDB(B1, 1, 1); PG8_STAGE(PG8_SB(1, 0), b3, voffB);
            PG8_BAR; PG8_WAIT_L(0); PG8_MMA(0, 1, At, B1); PG8_BAR;
            PG8_LDA(At, 1, 1); PG8_STAGE(PG8_SA(1, 0), a3, voffA);
            PG8_BAR; PG8_WAIT_L(0); PG8_MMA(1, 0, At, B0); PG8_BAR; PG8_SCHED;
            PG8_STAGE(PG8_SB(1, 1), b3 + hstepB, voffB);
            PG8_WAIT_V(6); PG8_BAR; PG8_MMA(1, 1, At, B1); PG8_BAR;
            }
        }
        if constexpr (ALIGN_EPI) { if (wr == 0) PG8_BAR; }
        if constexpr (FP8) { asm volatile("s_nop 15\n\ts_nop 15" ::: "memory"); __builtin_amdgcn_sched_barrier(0); }
        if constexpr (!Epi::AFTER_DRAIN) { E(acc, cur, wr, wc, fr, fq); S.done(cur); }
        if (!has_next) break;
#pragma unroll
        for (int a = 0; a < 2; ++a)
#pragma unroll
            for (int b = 0; b < 2; ++b)
#pragma unroll
                for (int m = 0; m < 4; ++m)
#pragma unroll
                    for (int n = 0; n < 2; ++n) acc[a][b][m][n] = (f32x4){0.f, 0.f, 0.f, 0.f};
        cur = nxt; cA = nA; cB = nB; ++ui;
        if constexpr (ALIGN_EPI) { if (wr == 1) PG8_BAR; }
    }
    PG8_WAIT_V(0);
    if constexpr (!ALIGN_EPI) { if (wr == 0) PG8_BAR; }
    PG8_BAR;
    if constexpr (Epi::AFTER_DRAIN) { E.fused(acc, cur, wr, wc, fr, fq, lds, wid, lane); S.done(cur); }
#undef PG8_SA
#undef PG8_SB
#undef PG8_STAGE
#undef PG8_LDA
#undef PG8_LDB
#undef PG8_MMA
#undef PG8_WAIT_V
#undef PG8_WAIT_L
#undef PG8_BAR
#undef PG8_SCHED
}
}

#define PG8_SP2 true
#define PG8_ALIGN true

#define XB_TMO      128
#define XB_XCNT(j)  (256  + 64 * (j))
#define XB_XSUB(j)  (1280 + 64 * (j))
#define XB_XGEN(j)  (2304 + 64 * (j))
#define XB_TOP      3328
#define XB_TOPGEN   3392
#define XCD_BAR_WORDS 3456
#define XB_SPIN_CAP (1u << 18)

__device__ __forceinline__ unsigned xb_ld(unsigned* p)              { return __hip_atomic_load(p, __ATOMIC_RELAXED, __HIP_MEMORY_SCOPE_AGENT); }
__device__ __forceinline__ unsigned xb_add(unsigned* p, unsigned v) { return __hip_atomic_fetch_add(p, v, __ATOMIC_RELAXED, __HIP_MEMORY_SCOPE_AGENT); }
__device__ __forceinline__ unsigned xb_xcc_id() { return (unsigned)__builtin_amdgcn_s_getreg((3 << 11) | 20) & 0xFu; }
#define XB_SPIN(cond, bar) do { unsigned _sp = 0; while (cond) { __builtin_amdgcn_s_sleep(1); \
    if ((++_sp & 255u) == 0u) { if (xb_ld(&(bar)[XB_TMO])) break; if (_sp > XB_SPIN_CAP) { atomicAdd(&(bar)[XB_TMO], 1u); break; } } } } while (0)

struct XcdBarrier {
    unsigned* bar; unsigned x;
    volatile LAS unsigned* st;
};
__device__ __forceinline__ XcdBarrier xcd_barrier_post(unsigned* bar, volatile LAS unsigned* st) {
    XcdBarrier b; b.bar = bar; b.x = xb_xcc_id(); b.st = st;
    if (threadIdx.x == 0) (void)xb_add(&bar[XB_XCNT(b.x)], 1u);
    return b;
}
__device__ __forceinline__ void xcd_barrier_complete(unsigned* bar, unsigned x, unsigned& nloc, unsigned& nx) {
    const unsigned G = gridDim.x * gridDim.y * gridDim.z;
    unsigned sum, cnt, mine, sp = 0u;
    for (;;) {
        sum = 0u; cnt = 0u; mine = 0u;
#pragma unroll
        for (unsigned j = 0; j < 16; ++j) { const unsigned c = xb_ld(&bar[XB_XCNT(j)]); sum += c; cnt += (c > 0u) ? 1u : 0u; mine = (j == x) ? c : mine; }
        if (sum == G) break;
        __builtin_amdgcn_s_sleep(1);
        if ((++sp & 255u) == 0u) { if (xb_ld(&bar[XB_TMO])) break; if (sp > XB_SPIN_CAP) { atomicAdd(&bar[XB_TMO], 1u); break; } }
    }
    nloc = mine > 0u ? mine : 1u; nx = cnt > 0u ? cnt : 1u;
}
__device__ __forceinline__ void xcd_barrier(const XcdBarrier& b) {
    asm volatile("s_waitcnt vmcnt(0)" ::: "memory");
    __syncthreads();
    if (threadIdx.x == 0) {
        unsigned* bar = b.bar;
        __builtin_amdgcn_s_waitcnt(0);
        unsigned nloc = b.st[0], nx = b.st[1];
        if (nloc == 0u) { xcd_barrier_complete(bar, b.x, nloc, nx); b.st[0] = nloc; b.st[1] = nx; }
        const unsigned old = xb_add(&bar[XB_XSUB(b.x)], 1u);
        const unsigned gen = old / nloc;
        if (old + 1u == (gen + 1u) * nloc) {
            __builtin_amdgcn_fence(__ATOMIC_RELEASE, "agent");
            asm volatile("s_waitcnt vmcnt(0)" ::: "memory");
            const unsigned og = xb_add(&bar[XB_TOP], 1u);
            const unsigned tg = og / nx;
            if (og + 1u == (tg + 1u) * nx) xb_add(&bar[XB_TOPGEN], 1u);
            else XB_SPIN(xb_ld(&bar[XB_TOPGEN]) == tg, bar);
            __builtin_amdgcn_fence(__ATOMIC_ACQUIRE, "agent");
            xb_add(&bar[XB_XGEN(b.x)], 1u);
            asm volatile("s_waitcnt vmcnt(0)" ::: "memory");
        } else {
            XB_SPIN(xb_ld(&bar[XB_XGEN(b.x)]) == gen, bar);
            __builtin_amdgcn_fence(__ATOMIC_ACQUIRE, "agent");
            asm volatile("s_waitcnt vmcnt(0)" ::: "memory");
        }
    }
    __syncthreads();
}

#define LDS_WAIT() asm volatile("s_waitcnt lgkmcnt(0)" ::: "memory")

__device__ __forceinline__ void transpose_item(const float* W, int K, int N, int k0, int n0, bf16_t* dst_row0, LAS float* scr, int lane) {
#pragma unroll 8
    for (int i = 0; i < 32; ++i) { const int kk = 2 * i + (lane >> 5); scr[kk * 33 + (lane & 31)] = W[(size_t)(k0 + kk) * N + n0 + (lane & 31)]; }
    LDS_WAIT(); asm volatile("" ::: "memory");
    const int c = lane & 7;
#pragma unroll
    for (int j = 0; j < 4; ++j) { const int n = (lane >> 3) + 8 * j; const LAS float* s = scr + (8 * c) * 33 + n;
        u32x4 o; o.x = pk2(s[0 * 33], s[1 * 33]); o.y = pk2(s[2 * 33], s[3 * 33]); o.z = pk2(s[4 * 33], s[5 * 33]); o.w = pk2(s[6 * 33], s[7 * 33]);
        *(u32x4*)(dst_row0 + (size_t)n * K + k0 + 8 * c) = o; }
    LDS_WAIT(); asm volatile("" ::: "memory");
}
__device__ __forceinline__ void transpose_item8(const float* W, int K, int N, int k0, int n0, unsigned char* dst_row0, float sc, LAS float* scr, int lane) {
#pragma unroll 8
    for (int i = 0; i < 32; ++i) { const int kk = 2 * i + (lane >> 5); scr[kk * 33 + (lane & 31)] = W[(size_t)(k0 + kk) * N + n0 + (lane & 31)]; }
    LDS_WAIT(); asm volatile("" ::: "memory");
    const int c = lane & 7;
#pragma unroll
    for (int j = 0; j < 4; ++j) { const int n = (lane >> 3) + 8 * j; const LAS float* s = scr + (8 * c) * 33 + n;
        u32x2 o; o.x = pg8::pk_fp8x4(s[0 * 33] * sc, s[1 * 33] * sc, s[2 * 33] * sc, s[3 * 33] * sc); o.y = pg8::pk_fp8x4(s[4 * 33] * sc, s[5 * 33] * sc, s[6 * 33] * sc, s[7 * 33] * sc);
        *(u32x2*)(dst_row0 + (size_t)n * K + k0 + 8 * c) = o; }
    LDS_WAIT(); asm volatile("" ::: "memory");
}
constexpr float SC_H8 = 8.0f, SC_WGU8 = 128.0f, SC_ACT8 = 8.0f, SC_WDN8 = 512.0f, SC_WIN8 = 128.0f, SC_MIX8 = 8.0f, SC_WOUT8 = 256.0f;
constexpr int IT_IN = (D / 64) * (INW / 32), IT_OUT = (D / 64) * (D / 32), IT_GU = (D / 64) * (NGU / 32), IT_DN = (DFF / 64) * (D / 32), IT_POOL = 4 * (256 / 64) * (256 / 32);
constexpr int IT_LAYER = IT_IN + IT_OUT + IT_GU + IT_DN + IT_POOL;
__device__ __forceinline__ void convert_weights(const float* w_in, const float* w_out, const float* w_gu, const float* w_down, const float* w_pool, unsigned char* ws, LAS unsigned char* lds, int wave, int lane) {
    LAS float* scr = (LAS float*)(lds + wave * 16384);
    const int gw = blockIdx.x * 8 + wave, NGW = gridDim.x * 8;
    for (int it = gw; it < DEPTH * IT_LAYER; it += NGW) {
        const int l = it / IT_LAYER; int r = it % IT_LAYER;
        if (r < IT_IN) { const int nblk = INW / 32, kb = r / nblk, nb = r % nblk, n0 = nb * 32;
            const float* src = w_in + (size_t)l * D * INW;
            if (n0 < 2048) { transpose_item(src, D, INW, kb * 64, n0, (bf16_t*)(ws + WS_WIN) + ((size_t)l * NZ + n0) * D, scr, lane);
                transpose_item8(src, D, INW, kb * 64, n0, (unsigned char*)(ws + WS_WIN8) + ((size_t)l * NZ + n0) * D, SC_WIN8, scr, lane); }
            else if (n0 < 3072) transpose_item8(src, D, INW, kb * 64, n0, (unsigned char*)(ws + WS_WIN8) + ((size_t)l * NZ + n0) * D, SC_WIN8, scr, lane);
            else if (n0 < 3104) transpose_item(src, D, INW, kb * 64, n0, (bf16_t*)(ws + WS_WG) + ((size_t)l * 32) * D, scr, lane);
            else transpose_item8(src, D, INW, kb * 64, n0, (unsigned char*)(ws + WS_WIN8) + ((size_t)l * NZ + n0 - 32) * D, SC_WIN8, scr, lane);
            continue; }
        r -= IT_IN;
        if (r < IT_OUT) { const int nblk = D / 32, kb = r / nblk, nb = r % nblk, n0 = nb * 32;
            transpose_item8(w_out + (size_t)l * D * D, D, D, kb * 64, n0, (unsigned char*)(ws + WS_WOUT) + ((size_t)l * D + n0) * D, SC_WOUT8, scr, lane); continue; }
        r -= IT_OUT;
        if (r < IT_GU) { const int nblk = NGU / 32, kb = r / nblk, nb = r % nblk, n0 = nb * 32;
            const int up = n0 >= DFF ? 1 : 0, j = n0 - up * DFF, drow = 256 * (j >> 7) + 128 * up + (j & 127);
            transpose_item8(w_gu + (size_t)l * D * NGU, D, NGU, kb * 64, n0, (unsigned char*)(ws + WS_WGU) + ((size_t)l * NGU + drow) * D, SC_WGU8, scr, lane); continue; }
        r -= IT_GU;
        if (r < IT_DN) { const int nblk = D / 32, kb = r / nblk, nb = r % nblk, n0 = nb * 32;
            transpose_item8(w_down + (size_t)l * DFF * D, DFF, D, kb * 64, n0, (unsigned char*)(ws + WS_WDN) + ((size_t)l * D + n0) * DFF, SC_WDN8, scr, lane); continue; }
        r -= IT_DN;
        { const int g = r >> 5, rr = r & 31, kb = rr >> 3, nb = rr & 7, n0 = nb * 32;
            transpose_item(w_pool + ((size_t)l * 4 + g) * 65536, 256, 256, kb * 64, n0, (bf16_t*)(ws + WS_WPOOL) + ((size_t)(l * 4 + g) * 256 + n0) * 256, scr, lane); }
    }
}
__device__ __forceinline__ void compute_mods(const float* c, const float* c_ctx, const float* w_ada, const float* b_ada, float* MODS, LAS unsigned char* lds, int tid, int wave, int lane) {
    LAS float* st = (LAS float*)lds;
    LAS float* red = (LAS float*)(lds + NMOD * D * 4);
    for (int idx = tid; idx < NMOD * D; idx += 512) { const int i = idx / D, k = idx % D; const float v = (i < 8) ? c[i * D + k] : c_ctx[k]; st[idx] = silu_f(v); }
    __syncthreads();
    for (int unit = blockIdx.x; unit < DEPTH * (MODW / 64); unit += gridDim.x) {
        const int l = unit / (MODW / 64), n0 = (unit % (MODW / 64)) * 64;
        f32x4 acc[NMOD];
#pragma unroll
        for (int i = 0; i < NMOD; ++i) acc[i] = (f32x4){0.f, 0.f, 0.f, 0.f};
        const float* wp = w_ada + ((size_t)l * D + wave * 256 + (lane >> 4)) * MODW + n0 + 4 * (lane & 15);
#pragma unroll 4
        for (int it = 0; it < 64; ++it) {
            const f32x4 wv = *(const f32x4*)(wp + (size_t)it * 4 * MODW);
            const int k = wave * 256 + it * 4 + (lane >> 4);
#pragma unroll
            for (int i = 0; i < NMOD; ++i) { const float s = st[i * D + k]; acc[i] += wv * s; }
        }
#pragma unroll
        for (int i = 0; i < NMOD; ++i) {
#pragma unroll
            for (int j = 0; j < 4; ++j) { float v = acc[i][j]; v += __shfl_xor(v, 16); v += __shfl_xor(v, 32); acc[i][j] = v; }
            if (lane < 16) *(LAS f32x4*)(red + (wave * NMOD + i) * 64 + 4 * lane) = acc[i];
        }
        __syncthreads();
        for (int idx = tid; idx < NMOD * 64; idx += 512) { const int i = idx >> 6, cc = idx & 63; float s = b_ada[(size_t)l * MODW + n0 + cc];
#pragma unroll
            for (int w = 0; w < 8; ++w) s += red[(w * NMOD + i) * 64 + cc];
            MODS[((size_t)l * NMOD + i) * MODW + n0 + cc] = s; }
        __syncthreads();
    }
}

template <int MODE, int HFMT>
__device__ __forceinline__ void ln_row(const u32x4 (&xr)[4], const u32x4 (&mr)[4], const f32x4 (&xf)[8], int row, bf16_t* X, bf16_t* H, unsigned char* H8, float* OUT, bool write_h,
                                       const LAS float* Vg, const LAS float* Vn, const LAS float* Vb, const LAS float* Vc, const LAS float* Vs, int lane) {
    float v[32]; float s = 0.f;
#pragma unroll
    for (int j = 0; j < 4; ++j) { const int col = 8 * lane + 512 * j;
        if (MODE == 1) { const f32x4 g0 = *(const LAS f32x4*)(Vg + col), g1 = *(const LAS f32x4*)(Vg + col + 4);
            const unsigned xw[4] = {xr[j].x, xr[j].y, xr[j].z, xr[j].w}, mw[4] = {mr[j].x, mr[j].y, mr[j].z, mr[j].w};
#pragma unroll
            for (int e = 0; e < 4; ++e) { const float ga = e < 2 ? g0[2 * e] : g1[2 * e - 4], gb = e < 2 ? g0[2 * e + 1] : g1[2 * e - 3];
                v[8 * j + 2 * e] = h2lo(xw[e]) * ALPHA + ga * bflo(mw[e]); v[8 * j + 2 * e + 1] = h2hi(xw[e]) * ALPHA + gb * bfhi(mw[e]); } }
        else {
#pragma unroll
            for (int e = 0; e < 4; ++e) { v[8 * j + e] = xf[2 * j][e]; v[8 * j + 4 + e] = xf[2 * j + 1][e]; } }
#pragma unroll
        for (int e = 0; e < 8; e += 2) s += v[8 * j + e] + v[8 * j + e + 1]; }
    const float mean = wave_sum(s) * (1.f / D); float s2 = 0.f;
#pragma unroll
    for (int i = 0; i < 32; ++i) { v[i] -= mean; s2 += v[i] * v[i]; }
    const float rstd = 1.f / sqrtf(wave_sum(s2) * (1.f / D) + LN_EPS);
#pragma unroll
    for (int j = 0; j < 4; ++j) { const int col = 8 * lane + 512 * j;
        const f32x4 n0 = *(const LAS f32x4*)(Vn + col), n1 = *(const LAS f32x4*)(Vn + col + 4), b0 = *(const LAS f32x4*)(Vb + col), b1 = *(const LAS f32x4*)(Vb + col + 4);
        float y[8];
#pragma unroll
        for (int e = 0; e < 8; ++e) y[e] = v[8 * j + e] * rstd * (e < 4 ? n0[e] : n1[e - 4]) + (e < 4 ? b0[e] : b1[e - 4]);
        if (OUT) { *(f32x4*)(OUT + (size_t)row * D + col) = (f32x4){y[0], y[1], y[2], y[3]}; *(f32x4*)(OUT + (size_t)row * D + col + 4) = (f32x4){y[4], y[5], y[6], y[7]}; }
        else { u32x4 w; w.x = pkh2(y[0], y[1]); w.y = pkh2(y[2], y[3]); w.z = pkh2(y[4], y[5]); w.w = pkh2(y[6], y[7]); *(u32x4*)(X + (size_t)row * D + col) = w; }
        if (write_h) { const f32x4 c0 = *(const LAS f32x4*)(Vc + col), c1 = *(const LAS f32x4*)(Vc + col + 4), h0 = *(const LAS f32x4*)(Vs + col), h1 = *(const LAS f32x4*)(Vs + col + 4);
            float h[8];
#pragma unroll
            for (int e = 0; e < 8; ++e) h[e] = y[e] * (e < 4 ? c0[e] : c1[e - 4]) + (e < 4 ? h0[e] : h1[e - 4]);
            if (HFMT == 0 || (HFMT == 2 && row < MP)) { u32x4 w; w.x = pg8::cvt_pk_bf16(h[0], h[1]); w.y = pg8::cvt_pk_bf16(h[2], h[3]); w.z = pg8::cvt_pk_bf16(h[4], h[5]); w.w = pg8::cvt_pk_bf16(h[6], h[7]); *(u32x4*)(H + (size_t)row * D + col) = w; }
            if (HFMT == 1 || HFMT == 2) { u32x2 w; w.x = pg8::pk_fp8x4(h[0] * SC_H8, h[1] * SC_H8, h[2] * SC_H8, h[3] * SC_H8); w.y = pg8::pk_fp8x4(h[4] * SC_H8, h[5] * SC_H8, h[6] * SC_H8, h[7] * SC_H8);
                *(u32x2*)(H8 + (size_t)row * D + col) = w; } }
        __builtin_amdgcn_sched_barrier(0); }
}
template <int MODE, int HFMT>
__device__ __forceinline__ void ln_phase(const float* xp, const float* xs, bf16_t* X, const bf16_t* MB, bf16_t* H, unsigned char* H8, float* OUT,
                                         const float* lng, const float* lnb, const float* modg, int goff, const float* modh, int shoff, int scoff, bool write_h,
                                         LAS unsigned char* lds, int tid, int wave, int lane) {
    LAS float* Vg = (LAS float*)lds;
    LAS float* Vn = Vg + D;
    LAS float* Vb = Vn + D;
    LAS float* Vc = Vb + D;
    LAS float* Vs = Vc + D;
    for (int grp = blockIdx.x; grp < MT / 32; grp += gridDim.x) {
        const int row0 = grp * 32, mi = row0 < MP ? 8 : ((row0 - MP) >> 11);
        { const int col = tid * 4;
          if (MODE == 1) *(LAS f32x4*)(Vg + col) = *(const f32x4*)(modg + (size_t)mi * MODW + goff + col);
          *(LAS f32x4*)(Vn + col) = *(const f32x4*)(lng + col); *(LAS f32x4*)(Vb + col) = *(const f32x4*)(lnb + col);
          if (write_h) { *(LAS f32x4*)(Vc + col) = *(const f32x4*)(modh + (size_t)mi * MODW + scoff + col) + 1.0f; *(LAS f32x4*)(Vs + col) = *(const f32x4*)(modh + (size_t)mi * MODW + shoff + col); } }
        const int r0 = row0 + wave * 4;
        if (MODE == 1) {
            u32x4 xr[4][4], mr[4][4];
#pragma unroll
            for (int k = 0; k < 4; ++k)
#pragma unroll
                for (int j = 0; j < 4; ++j) { xr[k][j] = *(const u32x4*)(X + (size_t)(r0 + k) * D + 8 * lane + 512 * j); mr[k][j] = *(const u32x4*)(MB + (size_t)(r0 + k) * D + 8 * lane + 512 * j); }
            __syncthreads();
            const f32x4 dummy[8] = {};
#pragma unroll
            for (int k = 0; k < 4; ++k) { ln_row<MODE, HFMT>(xr[k], mr[k], dummy, r0 + k, X, H, H8, OUT, write_h, Vg, Vn, Vb, Vc, Vs, lane); __builtin_amdgcn_sched_barrier(0); }
        } else {
            __syncthreads();
            const u32x4 dummy[4] = {};
#pragma unroll 1
            for (int kp = 0; kp < 2; ++kp) {
                f32x4 xf[2][8];
#pragma unroll
                for (int k = 0; k < 2; ++k) { const int row = r0 + 2 * kp + k; const float* src = row < MP ? xp + (size_t)row * D : xs + (size_t)(row - MP) * D;
#pragma unroll
                    for (int j = 0; j < 4; ++j) { xf[k][2 * j] = *(const f32x4*)(src + 8 * lane + 512 * j); xf[k][2 * j + 1] = *(const f32x4*)(src + 8 * lane + 512 * j + 4); } }
#pragma unroll
                for (int k = 0; k < 2; ++k) { ln_row<MODE, HFMT>(dummy, dummy, xf[k], r0 + 2 * kp + k, X, H, H8, OUT, write_h, Vg, Vn, Vb, Vc, Vs, lane); __builtin_amdgcn_sched_barrier(0); }
            }
        }
        __syncthreads();
    }
}

__device__ __forceinline__ bf16x8 fp8x8_to_bf16(u32x2 w) {
    const f32x2 a = __builtin_amdgcn_cvt_pk_f32_fp8((int)w.x, false), b = __builtin_amdgcn_cvt_pk_f32_fp8((int)w.x, true), c = __builtin_amdgcn_cvt_pk_f32_fp8((int)w.y, false), d = __builtin_amdgcn_cvt_pk_f32_fp8((int)w.y, true);
    u32x4 r; r.x = pg8::cvt_pk_bf16(a[0], a[1]); r.y = pg8::cvt_pk_bf16(b[0], b[1]); r.z = pg8::cvt_pk_bf16(c[0], c[1]); r.w = pg8::cvt_pk_bf16(d[0], d[1]);
    return __builtin_bit_cast(bf16x8, r);
}
__device__ __forceinline__ void gates_gemm(const bf16_t* H, const unsigned char* H8, const bf16_t* Wg, float* GATES, int wave, int lane) {
    const int gw = blockIdx.x * 8 + wave, NGW = gridDim.x * 8, c = lane & 15, g = lane >> 4;
    for (int task = gw; task < MT / 16; task += NGW) {
        const int row0 = task * 16; const bool prm = row0 < MP;
        f32x4 a0 = {0.f, 0.f, 0.f, 0.f}, a1 = {0.f, 0.f, 0.f, 0.f};
        const bf16_t* ap = H + (size_t)(row0 + c) * D + 8 * g; const unsigned char* ap8 = H8 + (size_t)(row0 + c) * D + 8 * g;
        const bf16_t* b0 = Wg + (size_t)c * D + 8 * g; const bf16_t* b1 = Wg + (size_t)(16 + c) * D + 8 * g;
#pragma unroll 1
        for (int kb = 0; kb < D / 256; ++kb) {
            bf16x8 av[8], bv0[8], bv1[8];
            if (prm) {
#pragma unroll
                for (int ks = 0; ks < 8; ++ks) av[ks] = *(const bf16x8*)(ap + kb * 256 + ks * 32);
            } else {
                u32x2 raw[8];
#pragma unroll
                for (int ks = 0; ks < 8; ++ks) raw[ks] = *(const u32x2*)(ap8 + kb * 256 + ks * 32);
#pragma unroll
                for (int ks = 0; ks < 8; ++ks) av[ks] = fp8x8_to_bf16(raw[ks]);
            }
#pragma unroll
            for (int ks = 0; ks < 8; ++ks) { bv0[ks] = *(const bf16x8*)(b0 + kb * 256 + ks * 32); bv1[ks] = *(const bf16x8*)(b1 + kb * 256 + ks * 32); }
            __builtin_amdgcn_sched_barrier(0);
#pragma unroll
            for (int ks = 0; ks < 8; ++ks) { a0 = __builtin_amdgcn_mfma_f32_16x16x32_bf16(av[ks], bv0[ks], a0, 0, 0, 0); a1 = __builtin_amdgcn_mfma_f32_16x16x32_bf16(av[ks], bv1[ks], a1, 0, 0, 0); }
        }
        const float sc = prm ? 1.0f : 1.0f / SC_H8;
#pragma unroll
        for (int r = 0; r < 4; ++r) { GATES[(size_t)(row0 + 4 * g + r) * 32 + c] = a0[r] * sc; GATES[(size_t)(row0 + 4 * g + r) * 32 + 16 + c] = a1[r] * sc; }
    }
}

__device__ __forceinline__ void gla_prep_unit(int u2, int l, const bf16_t* Z, const float* GATES, const float* w_a2, const float* b_a,
                                              bf16_t* QE, bf16_t* KDT, bf16_t* AM, float* DEC, LAS unsigned char* lds, int tid, int wave, int lane) {
    const int cg = u2 >> 2, h = u2 & 3, row0 = cg * 64;
    const int dir = tid >> 8, d = tid & 127, pg = (tid >> 7) & 1;
    const size_t u = (size_t)u2 * 2 + dir;
    LAS bf16_t* Rq = (LAS bf16_t*)lds;
    LAS bf16_t* Rk = (LAS bf16_t*)(lds + 17408);
    LAS bf16_t* Lq = (LAS bf16_t*)(lds + 34816 + dir * 34816);
    LAS bf16_t* Lk = Lq + 64 * 136;
    LAS float* La = (LAS float*)(lds + 104448);
    LAS float* Lt = (LAS float*)(lds + 104448 + 8192);
    { const int i = tid >> 3, part = tid & 7; *(LAS f32x4*)(La + i * 32 + part * 4) = *(const f32x4*)(GATES + (size_t)(row0 + i) * 32 + part * 4); }
#pragma unroll
    for (int k = 0; k < 2; ++k) { const int pc = tid + 512 * k, row = pc >> 4, part = pc & 15; const bf16_t* zp = Z + (size_t)(row0 + row) * NZ + h * DK + part * 8;
        *(LAS u32x4*)(Rq + row * 136 + part * 8) = *(const u32x4*)zp; *(LAS u32x4*)(Rk + row * 136 + part * 8) = *(const u32x4*)(zp + KW); }
    float w[16];
#pragma unroll
    for (int r = 0; r < 16; ++r) w[r] = w_a2[((size_t)(l * 2 + dir) * 16 + r) * KW + h * DK + d];
    const float bias = b_a[(size_t)(l * 2 + dir) * KW + h * DK + d];
    __syncthreads();
    float cs[32];
#pragma unroll
    for (int ii = 0; ii < 32; ++ii) { const int i = pg * 32 + ii; float x = bias;
#pragma unroll
        for (int r4 = 0; r4 < 4; ++r4) { const f32x4 a = *(const LAS f32x4*)(La + i * 32 + dir * 16 + r4 * 4); x += a[0] * w[r4 * 4] + a[1] * w[r4 * 4 + 1] + a[2] * w[r4 * 4 + 2] + a[3] * w[r4 * 4 + 3]; }
        const float ls = fminf(x, 0.f) - __logf(1.0f + __expf(-fabsf(x)));
        cs[ii] = ls * (1.0f / 16.0f); }
    float run = 0.f;
    if (dir == 0) {
#pragma unroll
        for (int ii = 0; ii < 32; ++ii) { run += cs[ii]; cs[ii] = run; }
    } else {
#pragma unroll
        for (int ii = 31; ii >= 0; --ii) { run += cs[ii]; cs[ii] = run; }
    }
    Lt[(dir * 2 + pg) * 128 + d] = run;
    __syncthreads();
    const float t0 = Lt[(dir * 2) * 128 + d], t1 = Lt[(dir * 2 + 1) * 128 + d];
    const float blast = t0 + t1;
    const float off = dir == 0 ? (pg == 1 ? t0 : 0.f) : (pg == 0 ? t1 : 0.f);
    const float elast = __expf(blast);
    unsigned kdw[16];
#pragma unroll
    for (int ii = 0; ii < 32; ii += 2) { const int i = pg * 32 + ii;
        const float b0 = off + cs[ii], b1 = off + cs[ii + 1];
        const float q0 = bf2f(Rq[i * 136 + d]), k0 = bf2f(Rk[i * 136 + d]), q1 = bf2f(Rq[(i + 1) * 136 + d]), k1 = bf2f(Rk[(i + 1) * 136 + d]);
        const float e0 = __expf(b0), e1 = __expf(b1), ke0 = k0 * __builtin_amdgcn_rcpf(e0), ke1 = k1 * __builtin_amdgcn_rcpf(e1);
        const unsigned qe = pg8::cvt_pk_bf16(q0 * QSCALE * e0, q1 * QSCALE * e1), ke = pg8::cvt_pk_bf16(ke0, ke1);
        kdw[ii >> 1] = pg8::cvt_pk_bf16(ke0 * elast, ke1 * elast);
        Lq[i * 136 + d] = (bf16_t)(qe & 0xffffu); Lq[(i + 1) * 136 + d] = (bf16_t)(qe >> 16);
        Lk[i * 136 + d] = (bf16_t)(ke & 0xffffu); Lk[(i + 1) * 136 + d] = (bf16_t)(ke >> 16); }
    { u32x4* kp = (u32x4*)(KDT + u * 8192 + d * 64 + pg * 32);
#pragma unroll
      for (int k = 0; k < 4; ++k) kp[k] = (u32x4){kdw[4 * k], kdw[4 * k + 1], kdw[4 * k + 2], kdw[4 * k + 3]}; }
    if (pg == 0) DEC[u * 128 + d] = elast;
    __syncthreads();
    { const int t2 = tid & 255;
#pragma unroll
      for (int k = 0; k < 4; ++k) { const int pc = t2 + 256 * k, row = pc >> 4, part = pc & 15; *(u32x4*)(QE + u * 8192 + row * 128 + part * 8) = *(const LAS u32x4*)(Lq + row * 136 + part * 8); } }
    const int c = lane & 15, g = lane >> 4;
#pragma unroll
    for (int tt = 0; tt < 4; ++tt) { const int T = (wave & 3) * 4 + tt, ti = T >> 2, tj = T & 3;
        f32x4 acc = {0.f, 0.f, 0.f, 0.f};
#pragma unroll
        for (int ks = 0; ks < 4; ++ks) { const bf16x8 a = *(const LAS bf16x8*)(Lq + (16 * ti + c) * 136 + 32 * ks + 8 * g), b = *(const LAS bf16x8*)(Lk + (16 * tj + c) * 136 + 32 * ks + 8 * g);
            acc = __builtin_amdgcn_mfma_f32_16x16x32_bf16(a, b, acc, 0, 0, 0); }
#pragma unroll
        for (int r = 0; r < 4; ++r) { const int i = 16 * ti + 4 * g + r, j = 16 * tj + c; const bool keep = dir == 0 ? (j <= i) : (j >= i);
            AM[u * 4096 + i * 64 + j] = (bf16_t)f2bf(keep ? acc[r] : 0.f); } }
    __syncthreads();
}

typedef short v4i16_t __attribute__((ext_vector_type(4)));
__device__ __forceinline__ s16x4 trrd(const LAS unsigned char* p) { return __builtin_bit_cast(s16x4, __builtin_amdgcn_ds_read_tr16_b64_v4i16((LAS v4i16_t*)p)); }
constexpr int SC_QE = 0, SC_KDT = 17408, SC_AM = 35840, SC_V = 45056, SC_DEC = 62464, SC_OST = 62976;
struct ScanRegs { u32x4 qe[2], kdt[2], am, v[2]; f32x4 dec; };
__device__ __forceinline__ void scan_fetch(ScanRegs& R, const bf16_t* Z, const bf16_t* QE, const bf16_t* KDT, const bf16_t* AM, const float* DEC, size_t u, int trow, int h, int half, int tid) {
#pragma unroll
    for (int k = 0; k < 2; ++k) { const int pc = tid + 512 * k; R.qe[k] = *(const u32x4*)(QE + u * 8192 + (pc >> 4) * 128 + (pc & 15) * 8); R.kdt[k] = *(const u32x4*)(KDT + u * 8192 + (pc >> 3) * 64 + (pc & 7) * 8);
        R.v[k] = *(const u32x4*)(Z + (size_t)(trow + (pc >> 4)) * NZ + 2 * KW + h * DV + half * 128 + (pc & 15) * 8); }
    R.am = *(const u32x4*)(AM + u * 4096 + (tid >> 3) * 64 + (tid & 7) * 8);
    R.dec = *(const f32x4*)(DEC + u * 128 + (tid & 31) * 4);
}
__device__ __forceinline__ void scan_commit(const ScanRegs& R, LAS unsigned char* lds, int tid) {
#pragma unroll
    for (int k = 0; k < 2; ++k) { const int pc = tid + 512 * k; *(LAS u32x4*)(lds + SC_QE + (pc >> 4) * 272 + (pc & 15) * 16) = R.qe[k]; *(LAS u32x4*)(lds + SC_KDT + (pc >> 3) * 144 + (pc & 7) * 16) = R.kdt[k];
        *(LAS u32x4*)(lds + SC_V + (pc >> 4) * 272 + (pc & 15) * 16) = R.v[k]; }
    *(LAS u32x4*)(lds + SC_AM + (tid >> 3) * 144 + (tid & 7) * 16) = R.am;
    if (tid < 32) *(LAS f32x4*)(lds + SC_DEC + tid * 16) = R.dec;
}
__device__ __forceinline__ void gla_scan_chain(int hchain, int l, const bf16_t* Z, const bf16_t* QE, const bf16_t* KDT, const bf16_t* AM, const float* DEC,
                                               const float* state_in, float* state_out, bf16_t* OF, bf16_t* OB, LAS unsigned char* lds, int tid, int wave, int lane) {
    const int half = hchain & 1, chain = hchain >> 1; const bool samp = chain < 64; const int id = samp ? chain : chain - 64;
    const int b = id >> 3, h = (id >> 1) & 3, dir = id & 1;
    const int rowbase = samp ? MP + b * L_S : b * L_P, nch = samp ? L_S / 64 : L_P / 64;
    bf16_t* O = dir == 0 ? OF : OB;
    const int c = lane & 15, g = lane >> 4, q = c >> 2, p = c & 3;
    const int col0 = half * 128 + 16 * wave + c;
    f32x4 S[8];
    if (samp) { const float* sp = state_in + ((size_t)((l * 2 + dir) * NB_S + b) * GH + h) * (DK * DV) + col0;
#pragma unroll
        for (int rt = 0; rt < 8; ++rt)
#pragma unroll
            for (int r = 0; r < 4; ++r) S[rt][r] = sp[(size_t)(16 * rt + 4 * g + r) * DV];
    } else {
#pragma unroll
        for (int rt = 0; rt < 8; ++rt) S[rt] = (f32x4){0.f, 0.f, 0.f, 0.f};
    }
    ScanRegs R;
    { const int ci0 = dir == 0 ? 0 : nch - 1; const int trow0 = rowbase + ci0 * 64;
      scan_fetch(R, Z, QE, KDT, AM, DEC, ((size_t)(trow0 >> 6) * GH + h) * 2 + dir, trow0, h, half, tid); }
    scan_commit(R, lds, tid);
    __syncthreads();
#pragma unroll 1
    for (int step = 0; step < nch; ++step) {
        const int ci = dir == 0 ? step : nch - 1 - step;
        const int trow = rowbase + ci * 64;
        if (step + 1 < nch) { const int cin = dir == 0 ? ci + 1 : ci - 1; const int trn = rowbase + cin * 64;
            scan_fetch(R, Z, QE, KDT, AM, DEC, ((size_t)(trn >> 6) * GH + h) * 2 + dir, trn, h, half, tid); }
#define SCQ(rt, ks, hf) (*(const LAS u32x2*)(lds + SC_QE + (16 * (rt) + c) * 272 + (32 * (ks) + 4 * g) * 2 + 32 * (hf)))
#define SCA(rt, ks) (*(const LAS bf16x8*)(lds + SC_AM + (16 * (rt) + c) * 144 + (32 * (ks) + 8 * g) * 2))
#define SCK(rt, ks) (*(const LAS bf16x8*)(lds + SC_KDT + (16 * (rt) + c) * 144 + (32 * (ks) + 8 * g) * 2))
#define SB0() __builtin_amdgcn_sched_barrier(0)
        bf16x8 Vb[2];
        u32x2 qa[2][4][2], qb[2][4][2];
#pragma unroll
        for (int ks = 0; ks < 2; ++ks) { const LAS unsigned char* vp = lds + SC_V + (32 * ks + 8 * g + q) * 272 + (16 * wave + 4 * p) * 2;
            const s16x4 lo = trrd(vp), hi = trrd(vp + 4 * 272);
            Vb[ks] = (bf16x8){lo[0], lo[1], lo[2], lo[3], hi[0], hi[1], hi[2], hi[3]}; }
#pragma unroll
        for (int ks = 0; ks < 2; ++ks)
#pragma unroll
            for (int rt = 0; rt < 4; ++rt) { qa[ks][rt][0] = SCQ(rt, ks, 0); qa[ks][rt][1] = SCQ(rt, ks, 1); }
        SB0();
        f32x4 o[4];
#pragma unroll
        for (int rt = 0; rt < 4; ++rt) o[rt] = (f32x4){0.f, 0.f, 0.f, 0.f};
#pragma unroll
        for (int ks = 0; ks < 2; ++ks)
#pragma unroll
            for (int rt = 0; rt < 4; ++rt) { qb[ks][rt][0] = SCQ(rt, ks + 2, 0); qb[ks][rt][1] = SCQ(rt, ks + 2, 1); }
#pragma unroll
        for (int ks = 0; ks < 2; ++ks) { const f32x4 lo = S[2 * ks], hi = S[2 * ks + 1];
            u32x4 sw; sw.x = pg8::cvt_pk_bf16(lo[0], lo[1]); sw.y = pg8::cvt_pk_bf16(lo[2], lo[3]); sw.z = pg8::cvt_pk_bf16(hi[0], hi[1]); sw.w = pg8::cvt_pk_bf16(hi[2], hi[3]);
            const bf16x8 Sb = __builtin_bit_cast(bf16x8, sw);
#pragma unroll
            for (int rt = 0; rt < 4; ++rt) o[rt] = __builtin_amdgcn_mfma_f32_16x16x32_bf16(__builtin_bit_cast(bf16x8, ((u32x4){qa[ks][rt][0].x, qa[ks][rt][0].y, qa[ks][rt][1].x, qa[ks][rt][1].y})), Sb, o[rt], 0, 0, 0); }
        SB0();
        bf16x8 fa[4][2];
#pragma unroll
        for (int rt = 0; rt < 4; ++rt) { fa[rt][0] = SCA(rt, 0); fa[rt][1] = SCA(rt, 1); }
#pragma unroll
        for (int ks = 0; ks < 2; ++ks) { const f32x4 lo = S[2 * ks + 4], hi = S[2 * ks + 5];
            u32x4 sw; sw.x = pg8::cvt_pk_bf16(lo[0], lo[1]); sw.y = pg8::cvt_pk_bf16(lo[2], lo[3]); sw.z = pg8::cvt_pk_bf16(hi[0], hi[1]); sw.w = pg8::cvt_pk_bf16(hi[2], hi[3]);
            const bf16x8 Sb = __builtin_bit_cast(bf16x8, sw);
#pragma unroll
            for (int rt = 0; rt < 4; ++rt) o[rt] = __builtin_amdgcn_mfma_f32_16x16x32_bf16(__builtin_bit_cast(bf16x8, ((u32x4){qb[ks][rt][0].x, qb[ks][rt][0].y, qb[ks][rt][1].x, qb[ks][rt][1].y})), Sb, o[rt], 0, 0, 0); }
        SB0();
        bf16x8 fk[4][2];
#pragma unroll
        for (int rt = 0; rt < 4; ++rt) { fk[rt][0] = SCK(rt, 0); fk[rt][1] = SCK(rt, 1); }
#pragma unroll
        for (int rt = 0; rt < 4; ++rt) {
            o[rt] = __builtin_amdgcn_mfma_f32_16x16x32_bf16(fa[rt][0], Vb[0], o[rt], 0, 0, 0);
            o[rt] = __builtin_amdgcn_mfma_f32_16x16x32_bf16(fa[rt][1], Vb[1], o[rt], 0, 0, 0); }
#pragma unroll
        for (int rt = 0; rt < 4; ++rt)
#pragma unroll
            for (int r = 0; r < 4; ++r) *(LAS bf16_t*)(lds + SC_OST + (16 * rt + 4 * g + r) * 272 + (16 * wave + c) * 2) = (bf16_t)f2bf(o[rt][r]);
        SB0();
        bf16x8 fk2[4][2];
#pragma unroll
        for (int rt = 0; rt < 4; ++rt) { fk2[rt][0] = SCK(rt + 4, 0); fk2[rt][1] = SCK(rt + 4, 1); }
#pragma unroll
        for (int rt = 0; rt < 4; ++rt) { S[rt] = S[rt] * *(const LAS f32x4*)(lds + SC_DEC + (16 * rt + 4 * g) * 4);
            S[rt] = __builtin_amdgcn_mfma_f32_16x16x32_bf16(fk[rt][0], Vb[0], S[rt], 0, 0, 0);
            S[rt] = __builtin_amdgcn_mfma_f32_16x16x32_bf16(fk[rt][1], Vb[1], S[rt], 0, 0, 0); }
        SB0();
#pragma unroll
        for (int rt = 4; rt < 8; ++rt) { S[rt] = S[rt] * *(const LAS f32x4*)(lds + SC_DEC + (16 * rt + 4 * g) * 4);
            S[rt] = __builtin_amdgcn_mfma_f32_16x16x32_bf16(fk2[rt - 4][0], Vb[0], S[rt], 0, 0, 0);
            S[rt] = __builtin_amdgcn_mfma_f32_16x16x32_bf16(fk2[rt - 4][1], Vb[1], S[rt], 0, 0, 0); }
#undef SCQ
#undef SCA
#undef SCK
#undef SB0
        __syncthreads();
#pragma unroll
        for (int k = 0; k < 2; ++k) { const int pc = tid + 512 * k, row = pc >> 4, part = pc & 15;
            *(u32x4*)(O + (size_t)(trow + row) * GW + h * DV + half * 128 + part * 8) = *(const LAS u32x4*)(lds + SC_OST + row * 272 + part * 16); }
        if (step + 1 < nch) scan_commit(R, lds, tid);
        __syncthreads();
    }
    if (!samp) { int ln2 = lane; asm volatile("" : "+v"(ln2));
        float* sp = state_out + ((size_t)((l * 2 + dir) * NB_P + b) * GH + h) * (DK * DV) + half * 128 + 16 * wave + (ln2 & 15) + (size_t)(4 * (ln2 >> 4)) * DV;
#pragma unroll
        for (int rt = 0; rt < 8; ++rt)
#pragma unroll
            for (int r = 0; r < 4; ++r) sp[(size_t)(16 * rt + r) * DV] = S[rt][r];
    }
}

__device__ __forceinline__ void pool_unit(int pu, const bf16_t* Z, bf16_t* POOLED, LAS unsigned char* lds, int tid) {
    const int ti = pu >> 6, g = (pu >> 4) & 3, cb = pu & 15, rowbase = ti * 2048, colbase = g * 256 + cb * 16, W = 2 << g;
    const bf16_t* src = Z + (size_t)rowbase * NZ + 3072 + colbase;
    LAS float* P = (LAS float*)lds;
#pragma unroll 4
    for (int it = 0; it < 8; ++it) { const int pc = tid + 512 * it, tok = pc >> 1, part = pc & 1;
        const u32x4 w = *(const u32x4*)(src + (size_t)tok * NZ + part * 8);
        LAS f32x4* d = (LAS f32x4*)(P + tok * 16 + part * 8);
        d[0] = (f32x4){bflo(w.x), bfhi(w.x), bflo(w.y), bfhi(w.y)}; d[1] = (f32x4){bflo(w.z), bfhi(w.z), bflo(w.w), bfhi(w.w)}; }
    __syncthreads();
    bf16_t* dst = POOLED + (size_t)rowbase * PW + colbase;
    if (ti >= 4) {
        { const int r = tid >> 4, ch = tid & 15; LAS float* p = P + (r * 64) * 16 + ch; float run = 0.f;
#pragma unroll 8
          for (int cc = 0; cc < 64; ++cc) { run += p[cc * 16]; p[cc * 16] = run; } }
        __syncthreads();
#pragma unroll 1
        for (int k = 0; k < 2; ++k) { const int item = tid + 512 * k, cc = item >> 4, ch = item & 15; LAS float* p = P + cc * 16 + ch; float run = 0.f;
#pragma unroll 8
          for (int r = 0; r < 32; ++r) { run += p[r * 1024]; p[r * 1024] = run; } }
        __syncthreads();
#pragma unroll 2
        for (int it = 0; it < 16; ++it) { const int item = tid + 512 * it, cq = item & 3, tok = item >> 2, r = tok >> 6, cc = tok & 63;
            const int lr = max(r - W / 2, 0), hr = min(r - W / 2 + W, 32), lc = max(cc - W / 2, 0), hc = min(cc - W / 2 + W, 64);
            const LAS float* p = P + cq * 4;
            f32x4 s = *(const LAS f32x4*)(p + ((hr - 1) * 64 + hc - 1) * 16);
            if (lr > 0) s -= *(const LAS f32x4*)(p + ((lr - 1) * 64 + hc - 1) * 16);
            if (lc > 0) s -= *(const LAS f32x4*)(p + ((hr - 1) * 64 + lc - 1) * 16);
            if (lr > 0 && lc > 0) s += *(const LAS f32x4*)(p + ((lr - 1) * 64 + lc - 1) * 16);
            const u32x2 ow = *(const u32x2*)(src + (size_t)tok * NZ + cq * 4);
            const f32x4 own = {bflo(ow.x), bfhi(ow.x), bflo(ow.y), bfhi(ow.y)};
            const f32x4 o = s * (1.0f / (float)((hr - lr) * (hc - lc))) - own;
            u32x2 w; w.x = pk2(o[0], o[1]); w.y = pk2(o[2], o[3]);
            *(u32x2*)(dst + (size_t)tok * PW + cq * 4) = w; }
    } else {
        if (tid < 128) { const int bb = tid >> 4, ch = tid & 15; LAS float* p = P + (bb * 256) * 16 + ch; float run = 0.f;
#pragma unroll 8
          for (int t = 0; t < 256; ++t) { run += p[t * 16]; p[t * 16] = run; } }
        __syncthreads();
#pragma unroll 2
        for (int it = 0; it < 16; ++it) { const int item = tid + 512 * it, cq = item & 3, tok = item >> 2, tt = tok & 255, base = tok - tt;
            const int lo = max(tt - W / 2, 0), hi = min(tt - W / 2 + W, 256);
            const LAS float* p = P + cq * 4;
            f32x4 s = *(const LAS f32x4*)(p + (base + hi - 1) * 16);
            if (lo > 0) s -= *(const LAS f32x4*)(p + (base + lo - 1) * 16);
            const u32x2 ow = *(const u32x2*)(src + (size_t)tok * NZ + cq * 4);
            const f32x4 own = {bflo(ow.x), bfhi(ow.x), bflo(ow.y), bfhi(ow.y)};
            const f32x4 o = s * (1.0f / (float)(hi - lo)) - own;
            u32x2 w; w.x = pk2(o[0], o[1]); w.y = pk2(o[2], o[3]);
            *(u32x2*)(dst + (size_t)tok * PW + cq * 4) = w; }
    }
    __syncthreads();
}
constexpr int NPOOLU = 12 * 4 * 16;

__device__ __forceinline__ void combine_phase(const bf16_t* OF, const bf16_t* OB, const bf16_t* Z, const float* gn, unsigned char* MIXED, int wave, int lane) {
    const int gw = blockIdx.x * 8 + wave, NGW = gridDim.x * 8;
    for (int row = gw; row < MT; row += NGW) {
#pragma unroll
        for (int j = 0; j < 2; ++j) { const int e = 8 * lane + 512 * j;
            const u32x4 a = *(const u32x4*)(OF + (size_t)row * GW + e), bq = *(const u32x4*)(OB + (size_t)row * GW + e), gg = *(const u32x4*)(Z + (size_t)row * NZ + 2048 + e);
            const f32x4 n0 = *(const f32x4*)(gn + e), n1 = *(const f32x4*)(gn + e + 4);
            float o[8], gt[8];
            o[0] = bflo(a.x) + bflo(bq.x); o[1] = bfhi(a.x) + bfhi(bq.x); o[2] = bflo(a.y) + bflo(bq.y); o[3] = bfhi(a.y) + bfhi(bq.y);
            o[4] = bflo(a.z) + bflo(bq.z); o[5] = bfhi(a.z) + bfhi(bq.z); o[6] = bflo(a.w) + bflo(bq.w); o[7] = bfhi(a.w) + bfhi(bq.w);
            gt[0] = bflo(gg.x); gt[1] = bfhi(gg.x); gt[2] = bflo(gg.y); gt[3] = bfhi(gg.y); gt[4] = bflo(gg.z); gt[5] = bfhi(gg.z); gt[6] = bflo(gg.w); gt[7] = bfhi(gg.w);
            float ss = 0.f;
#pragma unroll
            for (int k = 0; k < 8; ++k) ss += o[k] * o[k];
#pragma unroll
            for (int m = 1; m < 32; m <<= 1) ss += __shfl_xor(ss, m);
            const float r = 1.0f / sqrtf(ss * (1.0f / DV) + LN_EPS);
            float y[8];
#pragma unroll
            for (int k = 0; k < 8; ++k) y[k] = o[k] * r * (k < 4 ? n0[k] : n1[k - 4]) * silu_f(gt[k]);
            u32x2 w; w.x = pg8::pk_fp8x4(y[0] * SC_MIX8, y[1] * SC_MIX8, y[2] * SC_MIX8, y[3] * SC_MIX8); w.y = pg8::pk_fp8x4(y[4] * SC_MIX8, y[5] * SC_MIX8, y[6] * SC_MIX8, y[7] * SC_MIX8);
            *(u32x2*)(MIXED + (size_t)row * D + e) = w; }
    }
}

struct Args { const float* in[22]; float* out; unsigned char* ws; int ph_lo, ph_hi, nrep, pad; };
typedef __attribute__((address_space(4))) const Args* CArgsP;
__device__ __forceinline__ CArgsP get_args() { CArgsP p = (CArgsP)__builtin_amdgcn_kernarg_segment_ptr(); asm volatile("" : "+s"(p)); return p; }
#ifndef ONLY_PHASE
#define ONLY_PHASE -1
#endif
#define PHEN(k) (ONLY_PHASE < 0 || ONLY_PHASE == (k))
#ifndef PROBE_DUP
#define PROBE_DUP -1
#endif
#define REPS(k) for (int rep_ = 0; rep_ < ((PROBE_DUP == (k)) ? nrep : 1); ++rep_)
__global__ void __launch_bounds__(512, 2) mega_fwd(Args args) {
    extern __shared__ __attribute__((aligned(16))) unsigned char lds_raw[];
    LAS unsigned char* lds = (LAS unsigned char*)lds_raw;
    volatile LAS unsigned* MISC = (volatile LAS unsigned*)(lds + MISC_OFF);
    if (threadIdx.x < 16) MISC[threadIdx.x] = 0u;
    __syncthreads();
    const int ph_lo = args.ph_lo, ph_hi = args.ph_hi, nrep = args.nrep; (void)nrep;
    const bool one_launch = (ph_hi - ph_lo) > 1;
    XcdBarrier bar; bar.bar = (unsigned*)(args.ws + WS_CTL) + CW_BAR; bar.x = 0; bar.st = nullptr;
    if (one_launch) bar = xcd_barrier_post((unsigned*)(args.ws + WS_CTL) + CW_BAR, MISC + 8);
    int ph = 0;
#define RUN_PHASE() (ph >= ph_lo && ph < ph_hi)
#define SEAM() do { if (one_launch && ph >= ph_lo && ph + 1 < ph_hi) xcd_barrier(bar); ++ph; } while (0)
#define PHASE_LOCALS() int t_ = threadIdx.x; asm volatile("" : "+v"(t_)); const int tid = t_, lane = t_ & 63, wave = __builtin_amdgcn_readfirstlane(t_ >> 6); (void)lane; (void)wave; \
    CArgsP A = get_args(); unsigned char* ws = A->ws; const int G = gridDim.x; (void)G; (void)ws

    if (PHEN(0) && RUN_PHASE()) REPS(0) { PHASE_LOCALS();
        compute_mods(A->in[3], A->in[4], A->in[7], A->in[8], (float*)(ws + WS_MODS), lds, tid, wave, lane);
        __syncthreads();
        convert_weights(A->in[9], A->in[15], A->in[18], A->in[19], A->in[13], ws, lds, wave, lane);
    }
    SEAM();
    if (PHEN(1) && RUN_PHASE()) REPS(1) { PHASE_LOCALS();
        ln_phase<0, 2>(A->in[0], A->in[1], (bf16_t*)(ws + WS_X), nullptr, (bf16_t*)(ws + WS_H), (unsigned char*)(ws + WS_POOLED), nullptr, A->in[5], A->in[6], nullptr, 0, (const float*)(ws + WS_MODS), 0, D, true, lds, tid, wave, lane); }
    SEAM();

#pragma unroll 1
    for (int l = 0; l < DEPTH; ++l) {
        if (PHEN(2) && RUN_PHASE()) REPS(2) { PHASE_LOCALS();
            const bf16_t* H = (const bf16_t*)(ws + WS_H);
            { pg8::Gemm g{H, (const bf16_t*)(ws + WS_WIN) + (size_t)l * NZ * D, MP, 2048, D, D, D, 0}; pg8::StaticOrder S; S.init(MP, 2048, G, (int)blockIdx.x);
              pg8::EpiBf16<false> E{(bf16_t*)(ws + WS_Z), NZ, nullptr, 1.0f};
              pg8::gemm_phase<pg8::EpiBf16<false>, pg8::StaticOrder, PG8_ALIGN, PG8_SP2>(lds, g, S, E, tid); }
            gates_gemm(H, (const unsigned char*)(ws + WS_POOLED), (const bf16_t*)(ws + WS_WG) + (size_t)l * 32 * D, (float*)(ws + WS_GATES), wave, lane);
        }
        if (PHEN(12) && RUN_PHASE()) REPS(12) { PHASE_LOCALS();
            { pg8::Gemm g{(const bf16_t*)(ws + WS_POOLED) + (size_t)MP * (D / 2), (const bf16_t*)(ws + WS_WIN8) + (size_t)l * NZ * (D / 2), MS, NZ, D / 2, D / 2, D / 2, 0}; pg8::StaticOrder S; S.init(MS, NZ, G, (int)blockIdx.x);
              pg8::EpiBf16<false> E{(bf16_t*)(ws + WS_Z) + (size_t)MP * NZ, NZ, nullptr, 1.0f / (SC_H8 * SC_WIN8)};
              pg8::gemm_phase<pg8::EpiBf16<false>, pg8::StaticOrder, PG8_ALIGN, PG8_SP2, true>(lds, g, S, E, tid); }
        }
        if (PHEN(13) && RUN_PHASE()) REPS(13) { PHASE_LOCALS();
            { pg8::Gemm g{(const bf16_t*)(ws + WS_POOLED), (const bf16_t*)(ws + WS_WIN8) + ((size_t)l * NZ + 2048) * (D / 2), MP, 2048, D / 2, D / 2, D / 2, 0}; pg8::StaticOrder S; S.init(MP, 2048, G, (int)blockIdx.x);
              pg8::EpiBf16<false> E{(bf16_t*)(ws + WS_Z) + 2048, NZ, nullptr, 1.0f / (SC_H8 * SC_WIN8)};
              pg8::gemm_phase<pg8::EpiBf16<false>, pg8::StaticOrder, PG8_ALIGN, PG8_SP2, true>(lds, g, S, E, tid); }
        }
        SEAM();
        if (PHEN(3) && RUN_PHASE()) REPS(3) { PHASE_LOCALS();
            const bf16_t* Z = (const bf16_t*)(ws + WS_Z);
            for (int u = blockIdx.x; u < NPREP / 2; u += G) gla_prep_unit(u, l, Z, (const float*)(ws + WS_GATES), A->in[10], A->in[11], (bf16_t*)(ws + WS_QE), (bf16_t*)(ws + WS_KDT), (bf16_t*)(ws + WS_AM), (float*)(ws + WS_DEC), lds, tid, wave, lane);
            for (int pu = blockIdx.x; pu < NPOOLU; pu += G) pool_unit(pu, Z, (bf16_t*)(ws + WS_POOLED), lds, tid);
        }
        SEAM();
        if (PHEN(4) && RUN_PHASE()) REPS(4) { PHASE_LOCALS();
            const int bx = blockIdx.x;
            const bf16_t* Z = (const bf16_t*)(ws + WS_Z); const bf16_t* QE = (const bf16_t*)(ws + WS_QE); const bf16_t* KDT = (const bf16_t*)(ws + WS_KDT); const bf16_t* AM = (const bf16_t*)(ws + WS_AM);
            const float* DEC = (const float*)(ws + WS_DEC); const float* state_gla = A->in[2]; float* out_state = A->out + (size_t)MT * D; bf16_t* OF = (bf16_t*)(ws + WS_OF); bf16_t* OB = (bf16_t*)(ws + WS_OB);
            if (G >= 256) { const int stride = bx < 128 ? 4096 : G - 128; for (int ch = bx; ch < 640; ch += stride) gla_scan_chain(ch, l, Z, QE, KDT, AM, DEC, state_gla, out_state, OF, OB, lds, tid, wave, lane); }
            else { for (int ch = bx; ch < 640; ch += G) gla_scan_chain(ch, l, Z, QE, KDT, AM, DEC, state_gla, out_state, OF, OB, lds, tid, wave, lane); }
        }
        if (PHEN(11) && RUN_PHASE()) REPS(11) { PHASE_LOCALS();
            const int bx = blockIdx.x;
            pg8::Gemm g{(const bf16_t*)(ws + WS_POOLED), (const bf16_t*)(ws + WS_WPOOL) + (size_t)l * 4 * 65536, MT, 1024, 256, PW, 256, 512};
            pg8::StaticOrder S; if (G >= 256) S.init(MT, 1024, G - 128, bx - 128); else S.init(MT, 1024, G, bx);
            pg8::EpiFp8Col E{(unsigned char*)(ws + WS_MIXED) + GW, D, A->in[14] + (size_t)l * PW, SC_MIX8};
            pg8::gemm_phase<pg8::EpiFp8Col, pg8::StaticOrder, PG8_ALIGN, PG8_SP2>(lds, g, S, E, tid);
        }
        SEAM();
        if (PHEN(5) && RUN_PHASE()) REPS(5) { PHASE_LOCALS();
            combine_phase((const bf16_t*)(ws + WS_OF), (const bf16_t*)(ws + WS_OB), (const bf16_t*)(ws + WS_Z), A->in[12] + (size_t)l * GW, (unsigned char*)(ws + WS_MIXED), wave, lane); }
        SEAM();
        if (PHEN(6) && RUN_PHASE()) REPS(6) { PHASE_LOCALS();
            pg8::Gemm g{(const bf16_t*)(ws + WS_MIXED), (const bf16_t*)(ws + WS_WOUT) + (size_t)l * D * (D / 2), MT, D, D / 2, D / 2, D / 2, 0}; pg8::StaticOrder S; S.init(MT, D, G, (int)blockIdx.x);
            pg8::EpiBf16<false> E{(bf16_t*)(ws + WS_MB), D, nullptr, 1.0f / (SC_MIX8 * SC_WOUT8)};
            pg8::gemm_phase<pg8::EpiBf16<false>, pg8::StaticOrder, PG8_ALIGN, PG8_SP2, true>(lds, g, S, E, tid);
        }
        SEAM();
        if (PHEN(7) && RUN_PHASE()) REPS(7) { PHASE_LOCALS();
            const float* modl = (const float*)(ws + WS_MODS) + (size_t)l * NMOD * MODW;
            ln_phase<1, 1>(nullptr, nullptr, (bf16_t*)(ws + WS_X), (const bf16_t*)(ws + WS_MB), nullptr, (unsigned char*)(ws + WS_H), nullptr, A->in[16] + (size_t)l * D, A->in[17] + (size_t)l * D, modl, 2 * D, modl, 3 * D, 4 * D, true, lds, tid, wave, lane); }
        SEAM();
        if (PHEN(8) && RUN_PHASE()) REPS(8) { PHASE_LOCALS();
            pg8::Gemm g{(const bf16_t*)(ws + WS_H), (const bf16_t*)(ws + WS_WGU) + (size_t)l * NGU * (D / 2), MT, NGU, D / 2, D / 2, D / 2, 0}; pg8::StaticOrder S; S.init(MT, NGU, G, (int)blockIdx.x);
            pg8::EpiSwiGLU8 E{(unsigned char*)(ws + WS_ACT), DFF, 1.0f / (SC_H8 * SC_WGU8), SC_ACT8};
            pg8::gemm_phase<pg8::EpiSwiGLU8, pg8::StaticOrder, PG8_ALIGN, PG8_SP2, true>(lds, g, S, E, tid);
        }
        SEAM();
        if (PHEN(9) && RUN_PHASE()) REPS(9) { PHASE_LOCALS();
            pg8::Gemm g{(const bf16_t*)(ws + WS_ACT), (const bf16_t*)(ws + WS_WDN) + (size_t)l * D * (DFF / 2), MT, D, DFF / 2, DFF / 2, DFF / 2, 0}; pg8::StaticOrder S; S.init(MT, D, G, (int)blockIdx.x);
            pg8::EpiBf16<false> E{(bf16_t*)(ws + WS_MB), D, nullptr, 1.0f / (SC_ACT8 * SC_WDN8)};
            pg8::gemm_phase<pg8::EpiBf16<false>, pg8::StaticOrder, PG8_ALIGN, PG8_SP2, true>(lds, g, S, E, tid);
        }
        SEAM();
        if (PHEN(10) && RUN_PHASE()) REPS(10) { PHASE_LOCALS();
            const bool lastl = (l == DEPTH - 1);
            const float* modl = (const float*)(ws + WS_MODS) + (size_t)l * NMOD * MODW;
            ln_phase<1, 2>(nullptr, nullptr, (bf16_t*)(ws + WS_X), (const bf16_t*)(ws + WS_MB), (bf16_t*)(ws + WS_H), (unsigned char*)(ws + WS_POOLED), lastl ? A->out : nullptr, A->in[20] + (size_t)l * D, A->in[21] + (size_t)l * D, modl, 5 * D, modl + (size_t)NMOD * MODW, 0, D, !lastl, lds, tid, wave, lane);
        }
        SEAM();
    }
#undef RUN_PHASE
#undef SEAM
}
constexpr int N_PHASES = 2 + 9 * DEPTH;

#ifndef MK_SPLIT
#define MK_SPLIT 0
#endif
extern "C" void kernel_launch(void* const* d_in, const int* in_sizes, int n_in, void* d_out, int out_size, void* d_ws, size_t ws_size, hipStream_t stream) {
    static int grid = 0;
    if (grid == 0) {
        if (n_in != 22 || ws_size < WS_END) { fprintf(stderr, "kernel_launch: expected 22 inputs and >= %zu bytes of workspace; got %d, %zu\n", (size_t)WS_END, n_in, ws_size); grid = -1; return; }
        int dev = 0, cus = 0;
        if (hipGetDevice(&dev) != hipSuccess || hipDeviceGetAttribute(&cus, hipDeviceAttributeMultiprocessorCount, dev) != hipSuccess) { fprintf(stderr, "kernel_launch: device query failed\n"); grid = -1; return; }
        if (hipFuncSetAttribute((const void*)mega_fwd, hipFuncAttributeMaxDynamicSharedMemorySize, LDS_BYTES) != hipSuccess) { fprintf(stderr, "kernel_launch: hipFuncSetAttribute failed\n"); grid = -1; return; }
        int per_cu = 0;
        if (hipOccupancyMaxActiveBlocksPerMultiprocessor(&per_cu, (const void*)mega_fwd, 512, LDS_BYTES) != hipSuccess || per_cu < 1) fprintf(stderr, "kernel_launch: occupancy query says %d\n", per_cu);
        (void)hipGetLastError();
        grid = cus;
    }
    if (grid < 0) return;
    (void)in_sizes; (void)out_size;
    (void)hipMemsetAsync((char*)d_ws + WS_CTL, 0, CTL_ZERO_BYTES, stream);
    Args a{};
    for (int i = 0; i < 22; ++i) a.in[i] = (const float*)d_in[i];
    a.out = (float*)d_out; a.ws = (unsigned char*)d_ws; a.nrep = 2; a.pad = 0;
#if MK_SPLIT
    for (int p = 0; p < N_PHASES; ++p) { a.ph_lo = p; a.ph_hi = p + 1; hipLaunchKernelGGL(mega_fwd, dim3(grid), dim3(512), LDS_BYTES, stream, a); }
#else
    a.ph_lo = 0; a.ph_hi = N_PHASES;
    hipLaunchKernelGGL(mega_fwd, dim3(grid), dim3(512), LDS_BYTES, stream, a);
#endif
    const hipError_t le = hipPeekAtLastError();
    if (le != hipSuccess) fprintf(stderr, "kernel_launch: launch failed: %s\n", hipGetErrorName(le));
}
```
